# Optimizing an MI355X kernel written in HIP

```python
import jax, jax.numpy as jnp
from jax import lax
import numpy as np

D_MODEL = 2048
BATCH = 4
SEQ = 2048
DEPTH = 1
DEC_BATCH = 128
DEC_SEQ = 8
PAST_LEN = 16384
PAGE_SIZE = 128

N_META = 16
LRU_WIDTH = D_MODEL // 2
LRU_BLOCKS = 16
LRU_BLOCK = LRU_WIDTH // LRU_BLOCKS
CONV_W = 4
LRU_C = 8.0
RET_HEADS = 8
RET_WIDTH = D_MODEL // 2
RET_DK = RET_WIDTH // RET_HEADS
RET_DV = RET_WIDTH // RET_HEADS
CHUNK = 128
D_FF = 4 * D_MODEL
ROPE_BASE = 10000.0
EPS = 1e-6
PROJ_SIZES = (LRU_WIDTH, LRU_WIDTH, RET_WIDTH, RET_WIDTH, RET_WIDTH, RET_WIDTH, D_MODEL, D_MODEL)
D_PROJ = 2 * LRU_WIDTH + 4 * RET_WIDTH + 2 * D_MODEL

kernel_name = 'hawk_retnet_meta_hybrid_step'

F32 = jnp.float32


def rmsnorm(x, g):
    xf = x.astype(F32)
    y = xf * lax.rsqrt(jnp.mean(xf * xf, axis=-1, keepdims=True) + EPS)
    return (y * g.astype(F32)).astype(x.dtype)


def split_proj(proj):
    idx, acc = [], 0
    for s in PROJ_SIZES[:-1]:
        acc += s
        idx.append(acc)
    return jnp.split(proj, idx, axis=-1)


def rope(x, pos):
    d = x.shape[-1]
    inv = ROPE_BASE ** (-jnp.arange(0, d, 2, dtype=F32) / d)
    ang = pos.astype(F32)[:, None] * inv[None, :]
    cos = jnp.cos(ang)[None, :, None, :]
    sin = jnp.sin(ang)[None, :, None, :]
    xf = x.astype(F32)
    x1, x2 = xf[..., : d // 2], xf[..., d // 2:]
    return jnp.concatenate([x1 * cos - x2 * sin, x2 * cos + x1 * sin], axis=-1)


def causal_conv(u, buf, w, b):
    T = u.shape[1]
    full = jnp.concatenate([buf.astype(u.dtype), u], axis=1)
    out = full[:, 0:T] * w[0]
    for j in range(1, CONV_W):
        out = out + full[:, j:j + T] * w[j]
    return out + b, full[:, T:]


def rglru(u, h0, pos, wa, ba, wx, bx, lam):
    B, T, _ = u.shape
    uf = u.astype(F32)
    ub = uf.reshape(B, T, LRU_BLOCKS, LRU_BLOCK)
    rec_gate = jax.nn.sigmoid(jnp.einsum('btnc,ncd->btnd', ub, wa.astype(F32)).reshape(B, T, LRU_WIDTH) + ba)
    in_gate = jax.nn.sigmoid(jnp.einsum('btnc,ncd->btnd', ub, wx.astype(F32)).reshape(B, T, LRU_WIDTH) + bx)
    log_a = LRU_C * rec_gate * jax.nn.log_sigmoid(lam.astype(F32))
    a = jnp.exp(log_a)
    mult = jnp.sqrt(-jnp.expm1(2.0 * log_a))
    mult = jnp.where((pos == 0)[None, :, None], 1.0, mult)
    bterm = mult * in_gate * uf
    bterm = bterm.at[:, 0].add(a[:, 0] * h0.astype(F32))

    def comb(left, right):
        a1, b1 = left
        a2, b2 = right
        return a1 * a2, a2 * b1 + b2

    _, h = lax.associative_scan(comb, (a, bterm), axis=1)
    return h.astype(u.dtype), h[:, -1].astype(h0.dtype)


def ret_chunk(S, q, k, v, log_g):
    L = q.shape[1]
    n = jnp.arange(L, dtype=F32)
    diff = n[:, None] - n[None, :]
    causal = diff >= 0
    decay = jnp.where(causal[None], jnp.exp(log_g[:, None, None] * jnp.where(causal, diff, 0.0)[None]), 0.0)
    scores = jnp.einsum('blhd,bmhd->bhlm', q, k) * decay[None]
    intra = jnp.einsum('bhlm,bmhv->blhv', scores, v)
    inter = jnp.einsum('blhd,bhdv->blhv', q, S) * jnp.exp((n + 1.0)[:, None] * log_g[None, :])[None, :, :, None]
    kd = k * jnp.exp((L - 1.0 - n)[:, None] * log_g[None, :])[None, :, :, None]
    S_new = jnp.exp(L * log_g)[None, :, None, None] * S + jnp.einsum('blhd,blhv->bhdv', kd, v)
    return S_new, intra + inter


def retention(q, k, v, S0, lead):
    B, T = q.shape[0], q.shape[1]
    log_g = jnp.log1p(-jnp.exp2(-5.0 - jnp.arange(RET_HEADS, dtype=F32)))
    q, k, v = q.astype(F32), k.astype(F32), v.astype(F32)
    S = S0.astype(F32)
    outs = []
    if lead > 0:
        S, o_lead = ret_chunk(S, q[:, :lead], k[:, :lead], v[:, :lead], log_g)
        outs.append(o_lead)
    rest = T - lead
    c = CHUNK if rest % CHUNK == 0 else rest
    nc = rest // c

    def to_chunks(t):
        return jnp.moveaxis(t[:, lead:].reshape(B, nc, c, t.shape[2], t.shape[3]), 1, 0)

    def step(S_c, xs):
        qc, kc, vc = xs
        return ret_chunk(S_c, qc, kc, vc, log_g)

    S, o = lax.scan(step, S, (to_chunks(q), to_chunks(k), to_chunks(v)))
    outs.append(jnp.moveaxis(o, 0, 1).reshape(B, rest, RET_HEADS, RET_DV))
    return jnp.concatenate(outs, axis=1), S.astype(S0.dtype)


def head_norm(o, g):
    mu = jnp.mean(o, axis=-1, keepdims=True)
    var = jnp.mean(jnp.square(o - mu), axis=-1, keepdims=True)
    return (o - mu) * lax.rsqrt(var + EPS) * g.astype(F32).reshape(RET_HEADS, RET_DV)


def mixer(h, pos, lead, conv_buf, lru_h0, ret_S0, w_in, conv_w, conv_b, lru_wa, lru_ba, lru_wx, lru_bx,
          lru_lam, ret_norm_g, p_a, p_b, w_out):
    B, T, _ = h.shape
    xa, ga, q, k, v, g, gate_a, gate_b = split_proj(h @ w_in)
    xc, new_buf = causal_conv(xa, conv_buf, conv_w, conv_b)
    y_lru, h_last = rglru(xc, lru_h0, pos, lru_wa, lru_ba, lru_wx, lru_bx, lru_lam)
    ya = y_lru * jax.nn.gelu(ga)
    qh = rope(q.reshape(B, T, RET_HEADS, RET_DK), pos)
    kh = rope(k.reshape(B, T, RET_HEADS, RET_DK), pos) * (RET_DK ** -0.5)
    vh = v.reshape(B, T, RET_HEADS, RET_DV)
    o, S_last = retention(qh, kh, vh, ret_S0, lead)
    o = head_norm(o, ret_norm_g).reshape(B, T, RET_WIDTH).astype(h.dtype)
    yb = jax.nn.silu(g) * o
    merged = jax.nn.sigmoid(gate_a) * (ya @ p_a) + jax.nn.sigmoid(gate_b) * (yb @ p_b)
    return merged @ w_out, new_buf, h_last, S_last


def trunk(x, pos, lead, conv_bufs, lru_hs, ret_Ss, norm_mix_g, w_in, conv_w, conv_b, lru_wa, lru_ba,
          lru_wx, lru_bx, lru_lam, ret_norm_g, p_a, p_b, w_out, norm_ffn_g, w_up, w_down, norm_f_g):
    new_conv, new_lru, new_ret = [], [], []
    for l in range(DEPTH):
        h = rmsnorm(x, norm_mix_g[l])
        mix, cb, lh, rs = mixer(h, pos, lead, conv_bufs[l], lru_hs[l], ret_Ss[l], w_in[l], conv_w[l],
                                conv_b[l], lru_wa[l], lru_ba[l], lru_wx[l], lru_bx[l], lru_lam[l],
                                ret_norm_g[l], p_a[l], p_b[l], w_out[l])
        x = x + mix
        h = rmsnorm(x, norm_ffn_g[l])
        x = x + jnp.square(jax.nn.relu(h @ w_up[l])) @ w_down[l]
        new_conv.append(cb)
        new_lru.append(lh)
        new_ret.append(rs)
    return rmsnorm(x, norm_f_g), jnp.stack(new_conv), jnp.stack(new_lru), jnp.stack(new_ret)


def setup_inputs(seed: int = 0) -> dict:
    key = jax.random.key(seed)
    ks = jax.random.split(key, 24)

    def nrm(k, shape, scale):
        return jax.random.normal(k, shape, F32) * scale

    a_c = jax.random.uniform(ks[14], (DEPTH, LRU_WIDTH), F32, 0.9, 0.999)
    s = a_c ** (1.0 / LRU_C)
    return {
        'x_prompt': nrm(ks[0], (BATCH, SEQ, D_MODEL), 1.0),
        'x_sample': nrm(ks[1], (DEC_BATCH, DEC_SEQ, D_MODEL), 1.0),
        'state_conv': nrm(ks[2], (DEPTH, DEC_BATCH, CONV_W - 1, LRU_WIDTH), 1.0),
        'state_lru': nrm(ks[3], (DEPTH, DEC_BATCH, LRU_WIDTH), 1.0),
        'state_ret': nrm(ks[4], (DEPTH, DEC_BATCH, RET_HEADS, RET_DK, RET_DV), 1.0),
        'meta_tokens': nrm(ks[5], (N_META, D_MODEL), 1.0),
        'norm_mix_g': 1.0 + nrm(ks[6], (DEPTH, D_MODEL), 0.02),
        'w_in': nrm(ks[7], (DEPTH, D_MODEL, D_PROJ), D_MODEL ** -0.5),
        'conv_w': nrm(ks[8], (DEPTH, CONV_W, LRU_WIDTH), CONV_W ** -0.5),
        'conv_b': nrm(ks[9], (DEPTH, LRU_WIDTH), 0.02),
        'lru_wa': nrm(ks[10], (DEPTH, LRU_BLOCKS, LRU_BLOCK, LRU_BLOCK), LRU_BLOCK ** -0.5),
        'lru_ba': nrm(ks[11], (DEPTH, LRU_WIDTH), 0.02),
        'lru_wx': nrm(ks[12], (DEPTH, LRU_BLOCKS, LRU_BLOCK, LRU_BLOCK), LRU_BLOCK ** -0.5),
        'lru_bx': nrm(ks[13], (DEPTH, LRU_WIDTH), 0.02),
        'lru_lam': jnp.log(s) - jnp.log1p(-s),
        'ret_norm_g': 1.0 + nrm(ks[15], (DEPTH, RET_WIDTH), 0.02),
        'p_a': nrm(ks[16], (DEPTH, LRU_WIDTH, D_MODEL), LRU_WIDTH ** -0.5),
        'p_b': nrm(ks[17], (DEPTH, RET_WIDTH, D_MODEL), RET_WIDTH ** -0.5),
        'w_out': nrm(ks[18], (DEPTH, D_MODEL, D_MODEL), D_MODEL ** -0.5),
        'norm_ffn_g': 1.0 + nrm(ks[19], (DEPTH, D_MODEL), 0.02),
        'w_up': nrm(ks[20], (DEPTH, D_MODEL, D_FF), D_MODEL ** -0.5),
        'w_down': nrm(ks[21], (DEPTH, D_FF, D_MODEL), D_FF ** -0.5),
        'norm_f_g': 1.0 + nrm(ks[22], (D_MODEL,), 0.02),
    }


def reference(x_prompt, x_sample, state_conv, state_lru, state_ret, meta_tokens, norm_mix_g, w_in, conv_w,
              conv_b, lru_wa, lru_ba, lru_wx, lru_bx, lru_lam, ret_norm_g, p_a, p_b, w_out, norm_ffn_g,
              w_up, w_down, norm_f_g):
    weights = (norm_mix_g, w_in, conv_w, conv_b, lru_wa, lru_ba, lru_wx, lru_bx, lru_lam, ret_norm_g,
               p_a, p_b, w_out, norm_ffn_g, w_up, w_down, norm_f_g)
    B = x_prompt.shape[0]
    meta = jnp.broadcast_to(meta_tokens.astype(x_prompt.dtype)[None], (B, N_META, D_MODEL))
    xp = jnp.concatenate([meta, x_prompt], axis=1)
    pos_p = jnp.arange(N_META + x_prompt.shape[1], dtype=jnp.int32)
    conv0 = jnp.zeros((DEPTH, B, CONV_W - 1, LRU_WIDTH), state_conv.dtype)
    lru0 = jnp.zeros((DEPTH, B, LRU_WIDTH), state_lru.dtype)
    ret0 = jnp.zeros((DEPTH, B, RET_HEADS, RET_DK, RET_DV), state_ret.dtype)
    yp, new_conv_prompt, new_lru_prompt, new_ret_prompt = trunk(xp, pos_p, N_META, conv0, lru0, ret0, *weights)
    y_prompt = yp[:, N_META:]
    pos_s = PAST_LEN + jnp.arange(x_sample.shape[1], dtype=jnp.int32)
    y_sample, new_conv_sample, new_lru_sample, new_ret_sample = trunk(
        x_sample, pos_s, 0, state_conv, state_lru, state_ret, *weights)
    return (y_prompt, y_sample, new_conv_prompt, new_lru_prompt, new_ret_prompt,
            new_conv_sample, new_lru_sample, new_ret_sample)
```

```cpp
#include <hip/hip_runtime.h>
#include <cstdio>
#include <cstdint>

#ifndef MK_N_LAUNCHES
#define MK_N_LAUNCHES 1
#endif

#define LAS __attribute__((address_space(3)))
#define GAS __attribute__((address_space(1)))
typedef unsigned short bf16_t;
typedef short bf16x8 __attribute__((ext_vector_type(8)));
typedef float f32x4 __attribute__((ext_vector_type(4)));
typedef float f32x2 __attribute__((ext_vector_type(2)));
typedef unsigned u32x4 __attribute__((ext_vector_type(4)));
typedef unsigned u32x2 __attribute__((ext_vector_type(2)));
typedef GAS unsigned gu32;

constexpr int DM = 2048, NB = 4, SEQ = 2048, DECB = 128, DECS = 8, NMETA = 16;
constexpr int LW = 1024, NBLK = 16, BLK = 64, RH = 8, DK = 128, DFF = 8192, DPROJ = 10240;
constexpr int MP = NB * SEQ;
constexpr int MS = DECB * DECS;
constexpr int M = MP + MS;
constexpr int MROW_META = M;
constexpr int M1 = M + NMETA;
constexpr int M1PAD = 9472;
constexpr float EPS = 1e-6f;
constexpr int TABROWS = 2064 + 8;

constexpr size_t O_YP = 0, O_YS = 16777216, O_NCP = 18874368, O_NLP = 18886656, O_NRP = 18890752, O_NCS = 19415040, O_NLS = 19808256, O_NRS = 19939328, O_END = 36716544;

constexpr size_t MiB = 1u << 20;
constexpr size_t WS_CTL = 0, CTL_ZERO_BYTES = 1 * MiB;
constexpr size_t WS_TAB = 1 * MiB;
constexpr size_t WS_SS = 3 * MiB;
constexpr size_t WS_METAAB = 3 * MiB + 256 * 1024;
constexpr size_t WS_WIN = 4 * MiB;
constexpr size_t WS_WUP = 44 * MiB, WS_WDN = 76 * MiB, WS_WOUT = 108 * MiB, WS_PA = 116 * MiB, WS_PB = 120 * MiB;
constexpr size_t WS_H = 124 * MiB;
constexpr size_t WS_XA = 161 * MiB;
constexpr size_t SZ_P1 = (size_t)M1PAD * 1024 * 2;
constexpr size_t WS_GA = WS_XA + SZ_P1, WS_Q = WS_GA + SZ_P1, WS_K = WS_Q + SZ_P1, WS_V = WS_K + SZ_P1, WS_G = WS_V + SZ_P1, WS_SA = WS_G + SZ_P1, WS_SB = WS_SA + 2 * SZ_P1;
constexpr size_t WS_END = WS_SB + 2 * SZ_P1;
constexpr size_t WS_YA = WS_WIN, WS_YB = WS_WIN + (size_t)M * 1024 * 2, WS_X1N = WS_WIN, WS_MERGED = WS_H, WS_U = WS_XA;
static_assert(WS_END == 346 * MiB, "ws map");
static_assert(WS_U + (size_t)M * DFF * 2 <= WS_END, "u overlay");
constexpr int CW_BAR = 4096;

__device__ __forceinline__ float bf2f(unsigned b) { return __uint_as_float(b << 16); }
__device__ __forceinline__ unsigned f2bf(float f) { unsigned u = __float_as_uint(f); return (u + 0x7fffu + ((u >> 16) & 1u)) >> 16; }
__device__ __forceinline__ unsigned pk2(float lo, float hi) { return f2bf(lo) | (f2bf(hi) << 16); }
__device__ __forceinline__ unsigned cvt_pk_bf16(float lo, float hi) { unsigned r; asm volatile("v_cvt_pk_bf16_f32 %0, %1, %2" : "=v"(r) : "v"(lo), "v"(hi)); return r; }
__device__ __forceinline__ float fast_sigmoid(float x) { return __builtin_amdgcn_rcpf(1.0f + __builtin_amdgcn_exp2f(-1.4426950409f * x)); }
__device__ __forceinline__ float gelu_tanh(float x) { const float u = 1.5957691216f * (x + 0.044715f * x * x * x); return x * fast_sigmoid(u); }
__device__ __forceinline__ float silu_f(float x) { return x * fast_sigmoid(x); }
__device__ __forceinline__ float wave_sum(float v) {
#pragma unroll
    for (int o = 1; o < 64; o <<= 1) v += __shfl_xor(v, o);
    return v;
}
#define LDS_WAIT() asm volatile("s_waitcnt lgkmcnt(0)" ::: "memory")
#define VM_WAIT() asm volatile("s_waitcnt vmcnt(0)" ::: "memory")

__device__ const double INVF[64] = {1.0, 0.8659643233600653, 0.7498942093324559, 0.6493816315762113, 0.5623413251903491, 0.4869675251658631, 0.4216965034285822, 0.3651741272548377, 0.31622776601683794, 0.27384196342643613, 0.23713737056616552, 0.2053525026457146, 0.1778279410038923, 0.1539926526059492, 0.1333521432163324, 0.11547819846894582, 0.1, 0.08659643233600653, 0.07498942093324558, 0.06493816315762113, 0.05623413251903491, 0.04869675251658631, 0.042169650342858224, 0.03651741272548377, 0.03162277660168379, 0.027384196342643614, 0.023713737056616554, 0.02053525026457146, 0.01778279410038923, 0.01539926526059492, 0.01333521432163324, 0.011547819846894581, 0.01, 0.008659643233600654, 0.007498942093324558, 0.006493816315762113, 0.005623413251903491, 0.004869675251658631, 0.004216965034285823, 0.003651741272548377, 0.0031622776601683794, 0.0027384196342643613, 0.0023713737056616554, 0.002053525026457146, 0.0017782794100389228, 0.001539926526059492, 0.001333521432163324, 0.0011547819846894581, 0.001, 0.0008659643233600654, 0.0007498942093324559, 0.0006493816315762113, 0.0005623413251903491, 0.0004869675251658631, 0.00042169650342858224, 0.0003651741272548377, 0.00031622776601683794, 0.0002738419634264361, 0.00023713737056616554, 0.0002053525026457146, 0.00017782794100389227, 0.0001539926526059492, 0.0001333521432163324, 0.00011547819846894582};
__device__ __forceinline__ float lg2gamma(int h) {
    const float t[8] = {-0.04580368961312479f, -0.02272007650008353f, -0.011315313227834146f, -0.005646563141142063f, -0.0028205190623786626f, -0.0014095702546713536f, -0.0007046129765893727f, -0.0003522634716290214f};
    float r = t[0];
#pragma unroll
    for (int i = 1; i < 8; ++i) r = (h == i) ? t[i] : r;
    return r;
}

namespace pg8 {
constexpr int BM = 256, BK = 64, HALF = 128, HTB = HALF * BK * 2, STAGE_BYTES = 8 * HTB, NXCD = 8, WGM = 8;
__device__ __forceinline__ int lds_byte(int r, int c) { const int st = (r >> 4) * 2 + (c >> 5), rr = r & 15, cc = c & 31, ob = rr * 64 + cc * 2; return st * 1024 + (ob ^ (((ob >> 9) & 1) << 5)); }
__device__ __forceinline__ void stage_rc(int b, int& R, int& C) { const int st = b / 1024, sb = b % 1024, swz = sb ^ (((sb >> 9) & 1) << 5); R = (st >> 1) * 16 + swz / 64; C = (st & 1) * 32 + (swz % 64) / 2; }
__device__ __forceinline__ int perm32(int rho) { const int n = rho >> 4, i = rho & 15; return 8 * (i >> 2) + 4 * n + (i & 3); }
__device__ __forceinline__ int brow_perm(int R, int kind) {
    if (kind == 0) return (R & ~31) + perm32(R & 31);
    if (kind == 1) return ((R >> 5) << 4) + (R & 15) + (((R >> 4) & 1) << 6);
    return R;
}
struct Unit { int pm, pn; };
struct TileOrder {
    int nM, nN, nwg, G, c;
    __device__ void init(int nM_, int nN_, int G_, int c_) { nM = nM_; nN = nN_; nwg = nM * nN; G = G_; c = c_; }
    __device__ bool next(int i, Unit& u) const {
        const long L = (long)i * G + c; if (L >= nwg) return false;
        int wgid = (int)L; { const int q = nwg / NXCD, r = nwg % NXCD, xcd = wgid % NXCD, off = wgid / NXCD; wgid = (xcd < r ? xcd * (q + 1) : r * (q + 1) + (xcd - r) * q) + off; }
        const int nig = WGM * nN, gid = wgid / nig, fm = gid * WGM, gsz = (nM - fm) < WGM ? (nM - fm) : WGM;
        u.pm = fm + ((wgid % nig) % gsz); u.pn = (wgid % nig) / gsz; return true;
    }
};

template <class Epi, bool ALIGN_EPI, bool SP2>
__device__ __forceinline__ void gemm_phase(LAS unsigned char* lds, const bf16_t* Ag, const bf16_t* Btg, const int K, const TileOrder& S, const Epi& E) {
    const int tid = threadIdx.x, wid = __builtin_amdgcn_readfirstlane(tid >> 6), lane = tid & 63, wr = wid >> 2, wc = wid & 3, fr = lane & 15, fq = lane >> 4;
    const int nt = K / BK;
    int sR[2], sC[2];
    unsigned voffA[2], vBc[2], vBn[2];
#pragma unroll
    for (int i = 0; i < 2; ++i) { stage_rc(tid * 16 + i * 8192, sR[i], sC[i]); voffA[i] = (unsigned)(sR[i] * K + sC[i]) * 2u; }
    const size_t kstep = (size_t)(BK * 2);
    const size_t hstep = (size_t)HALF * K * 2;
    const size_t tstep = 2 * hstep;
    const unsigned ldsw = (unsigned)wid * 1024u;
    const int aoff = lds_byte(wr * 64 + fr, fq * 8), boff = lds_byte(wc * 32 + fr, fq * 8);
#define PG8_SA(b, h) (((b) * 2 + (h)) * HTB)
#define PG8_SB(b, h) ((4 + (b) * 2 + (h)) * HTB)
#define PG8_STAGE(bufoff, gbase, voff) do { _Pragma("unroll") for (int _i = 0; _i < 2; ++_i) \
        __builtin_amdgcn_global_load_lds((const unsigned*)((const char*)(gbase) + (voff)[_i]), (LAS unsigned*)(lds + (bufoff) + ldsw + _i * 8192), 16, 0, 0); } while (0)
#define PG8_LDA(dst, b, h) do { _Pragma("unroll") for (int m = 0; m < 4; ++m) _Pragma("unroll") for (int k = 0; k < 2; ++k) dst[m][k] = *(const LAS bf16x8*)(lds + PG8_SA(b, h) + aoff + m * 2048 + k * 1024); } while (0)
#define PG8_LDB(dst, b, h) do { _Pragma("unroll") for (int n = 0; n < 2; ++n) _Pragma("unroll") for (int k = 0; k < 2; ++k) dst[n][k] = *(const LAS bf16x8*)(lds + PG8_SB(b, h) + boff + n * 2048 + k * 1024); } while (0)
#define PG8_MMA(ai, bj, At, Bt) do { __builtin_amdgcn_s_setprio(1); _Pragma("unroll") for (int m = 0; m < 4; ++m) _Pragma("unroll") for (int n = 0; n < 2; ++n) _Pragma("unroll") for (int k = 0; k < 2; ++k) \
        acc[ai][bj][m][n] = __builtin_amdgcn_mfma_f32_16x16x32_bf16(Bt[n][k], At[m][k], acc[ai][bj][m][n], 0, 0, 0); __builtin_amdgcn_s_setprio(0); } while (0)
#define PG8_WAIT_V(n) asm volatile("s_waitcnt vmcnt(" #n ")" ::: "memory")
#define PG8_WAIT_L(n) asm volatile("s_waitcnt lgkmcnt(" #n ")" ::: "memory")
#define PG8_BAR __builtin_amdgcn_s_barrier()
#define PG8_SCHED __builtin_amdgcn_sched_barrier(0)
    Unit cur, nxt; int ui = 0;
    if (!S.next(0, cur)) return;
    { const int kind = E.bkind(cur);
#pragma unroll
      for (int i = 0; i < 2; ++i) { vBc[i] = (unsigned)(brow_perm(sR[i], kind) * K + sC[i]) * 2u; vBn[i] = vBc[i]; } }
    f32x4 acc[2][2][4][2];
#pragma unroll
    for (int a = 0; a < 2; ++a)
#pragma unroll
        for (int b = 0; b < 2; ++b)
#pragma unroll
            for (int m = 0; m < 4; ++m)
#pragma unroll
                for (int n = 0; n < 2; ++n) acc[a][b][m][n] = (f32x4){0.f, 0.f, 0.f, 0.f};
    bf16x8 At[4][2], B0[2][2], B1[2][2];
    const char* cA = (const char*)Ag + (size_t)cur.pm * tstep; const char* cB = (const char*)Btg + (size_t)cur.pn * tstep;
    if constexpr (SP2) {
        PG8_STAGE(PG8_SB(0, 0), cB, vBc); PG8_STAGE(PG8_SB(0, 1), cB + hstep, vBc); PG8_STAGE(PG8_SA(0, 0), cA, voffA); PG8_STAGE(PG8_SA(0, 1), cA + hstep, voffA);
        if (wr == 1) PG8_BAR;
        PG8_WAIT_V(2); PG8_BAR;
        PG8_STAGE(PG8_SB(1, 0), cB + kstep, vBc); PG8_STAGE(PG8_SA(1, 0), cA + kstep, voffA); PG8_STAGE(PG8_SB(1, 1), cB + hstep + kstep, vBc);
        PG8_WAIT_V(6); PG8_BAR;
    } else {
        PG8_STAGE(PG8_SB(0, 0), cB, vBc); PG8_STAGE(PG8_SA(0, 0), cA, voffA); PG8_STAGE(PG8_SB(0, 1), cB + hstep, vBc); PG8_STAGE(PG8_SA(0, 1), cA + hstep, voffA);
        if (wr == 1) PG8_BAR;
        PG8_WAIT_V(4); PG8_BAR;
        PG8_STAGE(PG8_SB(1, 0), cB + kstep, vBc); PG8_STAGE(PG8_SA(1, 0), cA + kstep, voffA); PG8_STAGE(PG8_SB(1, 1), cB + hstep + kstep, vBc);
        PG8_WAIT_V(6); PG8_BAR;
    }
    for (;;) {
        const bool has_next = S.next(ui + 1, nxt);
        const char* nA = has_next ? (const char*)Ag + (size_t)nxt.pm * tstep : cA; const char* nB = has_next ? (const char*)Btg + (size_t)nxt.pn * tstep : cB;
        if (has_next) { const int kind = E.bkind(nxt);
#pragma unroll
            for (int i = 0; i < 2; ++i) vBn[i] = (unsigned)(brow_perm(sR[i], kind) * K + sC[i]) * 2u; }
        for (int t = 0; t < nt; t += 2) {
            const bool last = (t == nt - 2);
            const char* a1 = cA + (size_t)(t + 1) * kstep;
            const char* a2 = last ? nA : cA + (size_t)(t + 2) * kstep; const char* b2 = last ? nB : cB + (size_t)(t + 2) * kstep;
            const char* a3 = a2 + kstep; const char* b3 = b2 + kstep;
            unsigned vB[2]; vB[0] = last ? vBn[0] : vBc[0]; vB[1] = last ? vBn[1] : vBc[1];
            if constexpr (SP2) {
            PG8_LDB(B0, 0, 0); PG8_LDB(B1, 0, 1); PG8_SCHED; PG8_LDA(At, 0, 0); PG8_STAGE(PG8_SA(1, 1), a1 + hstep, voffA);
            PG8_WAIT_V(8); PG8_WAIT_L(0); PG8_BAR; PG8_MMA(0, 0, At, B0); PG8_MMA(0, 1, At, B1); PG8_BAR; PG8_SCHED;
            PG8_LDA(At, 0, 1); PG8_STAGE(PG8_SB(0, 0), b2, vB); PG8_STAGE(PG8_SB(0, 1), b2 + hstep, vB); PG8_STAGE(PG8_SA(0, 0), a2, voffA);
            PG8_WAIT_V(8); PG8_WAIT_L(0); PG8_BAR; PG8_MMA(1, 0, At, B0); PG8_MMA(1, 1, At, B1); PG8_BAR; PG8_SCHED;
            PG8_LDB(B0, 1, 0); PG8_LDB(B1, 1, 1); PG8_SCHED; PG8_LDA(At, 1, 0); PG8_STAGE(PG8_SA(0, 1), a2 + hstep, voffA);
            PG8_WAIT_V(8); PG8_WAIT_L(0); PG8_BAR; PG8_MMA(0, 0, At, B0); PG8_MMA(0, 1, At, B1); PG8_BAR; PG8_SCHED;
            PG8_LDA(At, 1, 1); PG8_STAGE(PG8_SB(1, 0), b3, vB); PG8_STAGE(PG8_SB(1, 1), b3 + hstep, vB); PG8_STAGE(PG8_SA(1, 0), a3, voffA);
            PG8_WAIT_V(8); PG8_WAIT_L(0); PG8_BAR; PG8_MMA(1, 0, At, B0); PG8_MMA(1, 1, At, B1); PG8_BAR; PG8_SCHED;
            } else {
            PG8_LDB(B0, 0, 0); PG8_SCHED; PG8_LDA(At, 0, 0); PG8_STAGE(PG8_SA(1, 1), a1 + hstep, voffA);
            PG8_WAIT_L(8); PG8_BAR; PG8_WAIT_L(0); PG8_MMA(0, 0, At, B0); PG8_BAR; PG8_SCHED;
            PG8_LDB(B1, 0, 1); PG8_STAGE(PG8_SB(0, 0), b2, vB);
            PG8_BAR; PG8_WAIT_L(0); PG8_MMA(0, 1, At, B1); PG8_BAR;
            PG8_LDA(At, 0, 1); PG8_STAGE(PG8_SA(0, 0), a2, voffA);
            PG8_BAR; PG8_WAIT_L(0); PG8_MMA(1, 0, At, B0); PG8_BAR; PG8_SCHED;
            PG8_STAGE(PG8_SB(0, 1), b2 + hstep, vB);
            PG8_WAIT_V(6); PG8_BAR; PG8_MMA(1, 1, At, B1); PG8_BAR;
            PG8_LDB(B0, 1, 0); PG8_SCHED; PG8_LDA(At, 1, 0); PG8_STAGE(PG8_SA(0, 1), a2 + hstep, voffA);
            PG8_WAIT_L(8); PG8_BAR; PG8_WAIT_L(0); PG8_MMA(0, 0, At, B0); PG8_BAR; PG8_SCHED;
            PG8_LDB(B1, 1, 1); PG8_STAGE(PG8_SB(1, 0), b3, vB);
            PG8_BAR; PG8_WAIT_L(0); PG8_MMA(0, 1, At, B1); PG8_BAR;
            PG8_LDA(At, 1, 1); PG8_STAGE(PG8_SA(1, 0), a3, voffA);
            PG8_BAR; PG8_WAIT_L(0); PG8_MMA(1, 0, At, B0); PG8_BAR; PG8_SCHED;
            PG8_STAGE(PG8_SB(1, 1), b3 + hstep, vB);
            PG8_WAIT_V(6); PG8_BAR; PG8_MMA(1, 1, At, B1); PG8_BAR;
            }
        }
        if constexpr (ALIGN_EPI) { if (wr == 0) PG8_BAR; }
        E(acc, cur, wr, wc, fr, fq);
        if (!has_next) break;
#pragma unroll
        for (int a = 0; a < 2; ++a)
#pragma unroll
            for (int b = 0; b < 2; ++b)
#pragma unroll
                for (int m = 0; m < 4; ++m)
#pragma unroll
                    for (int n = 0; n < 2; ++n) acc[a][b][m][n] = (f32x4){0.f, 0.f, 0.f, 0.f};
        cur = nxt; cA = nA; cB = nB; ++ui; vBc[0] = vBn[0]; vBc[1] = vBn[1];
        if constexpr (ALIGN_EPI) { if (wr == 1) PG8_BAR; }
    }
    PG8_WAIT_V(0);
    if constexpr (!ALIGN_EPI) { if (wr == 0) PG8_BAR; }
    PG8_BAR;
#undef PG8_SA
#undef PG8_SB
#undef PG8_STAGE
#undef PG8_LDA
#undef PG8_LDB
#undef PG8_MMA
#undef PG8_WAIT_V
#undef PG8_WAIT_L
#undef PG8_BAR
#undef PG8_SCHED
}
}

using pg8::Unit;
typedef f32x4 AccT[2][2][4][2];

struct EpiProj {
    bf16_t *XA, *GA, *Q, *K, *V, *G, *SA, *SB; const float* COS; const float* SIN;
    __device__ __forceinline__ int bkind(const Unit& u) const { const int grp = u.pn >> 2; return (grp == 2 || grp == 3) ? 1 : 0; }
    __device__ __forceinline__ void operator()(const AccT& acc, const Unit& u, int wr, int wc, int fr, int fq) const {
        const int grp = u.pn >> 2;
        if (u.pm == 36 && !(grp == 0 || grp == 2 || grp == 3 || grp == 4)) return;
        const int row0 = u.pm * 256 + wr * 64 + fr;
        if (grp == 2 || grp == 3) {
            bf16_t* dst = (grp == 2) ? Q : K;
            const int c0 = 16 * wc + 4 * fq;
#pragma unroll
            for (int ai = 0; ai < 2; ++ai)
#pragma unroll
                for (int m = 0; m < 4; ++m) {
                    const int r = row0 + ai * 128 + m * 16;
                    if (r >= M1) continue;
                    int trow, nin;
                    if (r < MP) { trow = (r & 2047) + 16; nin = (r & 127) + 1; }
                    else if (r < M) { trow = 2064 + ((r - MP) & 7); nin = ((r - MP) & 7) + 1; }
                    else { trow = r - M; nin = r - M + 1; }
                    const f32x4 cs = *(const f32x4*)(COS + trow * 64 + c0), sn = *(const f32x4*)(SIN + trow * 64 + c0);
#pragma unroll
                    for (int bj = 0; bj < 2; ++bj) {
                        const int head = (u.pn & 3) * 2 + bj;
                        const float e = (float)nin * lg2gamma(head);
                        const float sc = (grp == 2) ? __builtin_amdgcn_exp2f(e) : 0.08838834764831845f * __builtin_amdgcn_exp2f(-e);
                        const f32x4 x1 = acc[ai][bj][m][0], x2 = acc[ai][bj][m][1];
                        const f32x4 o1 = (x1 * cs - x2 * sn) * sc, o2 = (x2 * cs + x1 * sn) * sc;
                        bf16_t* p = dst + (size_t)r * 1024 + head * 128 + c0;
                        u32x2 w1, w2; w1.x = cvt_pk_bf16(o1[0], o1[1]); w1.y = cvt_pk_bf16(o1[2], o1[3]); w2.x = cvt_pk_bf16(o2[0], o2[1]); w2.y = cvt_pk_bf16(o2[2], o2[3]);
                        *(u32x2*)p = w1; *(u32x2*)(p + 64) = w2;
                    }
                }
            return;
        }
        bf16_t* dst; int pitch, colt;
        if (grp == 0) { dst = XA; pitch = 1024; colt = (u.pn & 3) * 256; }
        else if (grp == 1) { dst = GA; pitch = 1024; colt = (u.pn & 3) * 256; }
        else if (grp == 4) { dst = V; pitch = 1024; colt = (u.pn & 3) * 256; }
        else if (grp == 5) { dst = G; pitch = 1024; colt = (u.pn & 3) * 256; }
        else if (grp < 8) { dst = SA; pitch = 2048; colt = (u.pn - 24) * 256; }
        else { dst = SB; pitch = 2048; colt = (u.pn - 32) * 256; }
        const int act = (grp == 1) ? 1 : (grp == 5) ? 2 : (grp >= 6) ? 3 : 0;
        const int col0 = colt + wc * 32 + 8 * fq;
#pragma unroll
        for (int ai = 0; ai < 2; ++ai)
#pragma unroll
            for (int m = 0; m < 4; ++m) {
                const int r = row0 + ai * 128 + m * 16;
                bf16_t* rowp = dst + (size_t)r * pitch + col0;
#pragma unroll
                for (int bj = 0; bj < 2; ++bj) {
                    f32x4 v0 = acc[ai][bj][m][0], v1 = acc[ai][bj][m][1];
                    if (act == 1) {
#pragma unroll
                        for (int j = 0; j < 4; ++j) { v0[j] = gelu_tanh(v0[j]); v1[j] = gelu_tanh(v1[j]); } }
                    else if (act == 2) {
#pragma unroll
                        for (int j = 0; j < 4; ++j) { v0[j] = silu_f(v0[j]); v1[j] = silu_f(v1[j]); } }
                    else if (act == 3) {
#pragma unroll
                        for (int j = 0; j < 4; ++j) { v0[j] = fast_sigmoid(v0[j]); v1[j] = fast_sigmoid(v1[j]); } }
                    u32x4 w; w.x = cvt_pk_bf16(v0[0], v0[1]); w.y = cvt_pk_bf16(v0[2], v0[3]); w.z = cvt_pk_bf16(v1[0], v1[1]); w.w = cvt_pk_bf16(v1[2], v1[3]);
                    *(u32x4*)(rowp + bj * 128) = w;
                }
            }
    }
};

struct EpiMergeA {
    const bf16_t* SA; float* T;
    __device__ __forceinline__ int bkind(const Unit&) const { return 2; }
    __device__ __forceinline__ void operator()(const AccT& acc, const Unit& u, int wr, int wc, int fr, int fq) const {
        const int row0 = u.pm * 256 + wr * 64 + fr, col0 = u.pn * 256 + wc * 32 + 4 * fq;
#pragma unroll
        for (int ai = 0; ai < 2; ++ai)
#pragma unroll
            for (int m = 0; m < 4; ++m) { const size_t off = (size_t)(row0 + ai * 128 + m * 16) * DM + col0;
#pragma unroll
                for (int bj = 0; bj < 2; ++bj)
#pragma unroll
                    for (int n = 0; n < 2; ++n) { const u32x2 s = *(const u32x2*)(SA + off + bj * 128 + n * 16);
                        f32x4 g; g[0] = bf2f(s.x & 0xffffu); g[1] = bf2f(s.x >> 16); g[2] = bf2f(s.y & 0xffffu); g[3] = bf2f(s.y >> 16);
                        *(f32x4*)(T + off + bj * 128 + n * 16) = acc[ai][bj][m][n] * g; } }
    }
};
struct EpiMergeB {
    const bf16_t* SB; const float* T; bf16_t* MG;
    __device__ __forceinline__ int bkind(const Unit&) const { return 2; }
    __device__ __forceinline__ void operator()(const AccT& acc, const Unit& u, int wr, int wc, int fr, int fq) const {
        const int row0 = u.pm * 256 + wr * 64 + fr, col0 = u.pn * 256 + wc * 32 + 4 * fq;
#pragma unroll
        for (int ai = 0; ai < 2; ++ai)
#pragma unroll
            for (int m = 0; m < 4; ++m) { const size_t off = (size_t)(row0 + ai * 128 + m * 16) * DM + col0;
#pragma unroll
                for (int bj = 0; bj < 2; ++bj)
#pragma unroll
                    for (int n = 0; n < 2; ++n) { const u32x2 s = *(const u32x2*)(SB + off + bj * 128 + n * 16);
                        f32x4 g; g[0] = bf2f(s.x & 0xffffu); g[1] = bf2f(s.x >> 16); g[2] = bf2f(s.y & 0xffffu); g[3] = bf2f(s.y >> 16);
                        const f32x4 t = *(const f32x4*)(T + off + bj * 128 + n * 16);
                        const f32x4 o = t + acc[ai][bj][m][n] * g;
                        u32x2 w; w.x = cvt_pk_bf16(o[0], o[1]); w.y = cvt_pk_bf16(o[2], o[3]);
                        *(u32x2*)(MG + off + bj * 128 + n * 16) = w; } }
    }
};
struct EpiRes1 {
    const float* xp; const float* xs; float* X1; bf16_t* X1N; const float* gf; float* ss;
    __device__ __forceinline__ int bkind(const Unit&) const { return 2; }
    __device__ __forceinline__ void operator()(const AccT& acc, const Unit& u, int wr, int wc, int fr, int fq) const {
        const int row0 = u.pm * 256 + wr * 64 + fr, col0 = u.pn * 256 + wc * 32 + 4 * fq;
        const float* xin = (u.pm < 32) ? xp : (xs - (size_t)MP * DM);
        f32x4 gv[2][2];
#pragma unroll
        for (int bj = 0; bj < 2; ++bj)
#pragma unroll
            for (int n = 0; n < 2; ++n) gv[bj][n] = *(const f32x4*)(gf + col0 + bj * 128 + n * 16);
#pragma unroll
        for (int ai = 0; ai < 2; ++ai)
#pragma unroll
            for (int m = 0; m < 4; ++m) { const int r = row0 + ai * 128 + m * 16; const size_t off = (size_t)r * DM + col0; float s = 0.f;
#pragma unroll
                for (int bj = 0; bj < 2; ++bj)
#pragma unroll
                    for (int n = 0; n < 2; ++n) { const f32x4 x = *(const f32x4*)(xin + off + bj * 128 + n * 16); const f32x4 o = x + acc[ai][bj][m][n];
                        *(f32x4*)(X1 + off + bj * 128 + n * 16) = o; s += (o[0] * o[0] + o[1] * o[1]) + (o[2] * o[2] + o[3] * o[3]);
                        const f32x4 h = o * gv[bj][n]; u32x2 w; w.x = cvt_pk_bf16(h[0], h[1]); w.y = cvt_pk_bf16(h[2], h[3]);
                        *(u32x2*)(X1N + off + bj * 128 + n * 16) = w; }
                s += __shfl_xor(s, 16); s += __shfl_xor(s, 32);
                if (fq == 0) atomicAdd(ss + r, s); }
    }
};
struct EpiUp {
    const float* ss; bf16_t* U;
    __device__ __forceinline__ int bkind(const Unit&) const { return 0; }
    __device__ __forceinline__ void operator()(const AccT& acc, const Unit& u, int wr, int wc, int fr, int fq) const {
        const int row0 = u.pm * 256 + wr * 64 + fr, col0 = u.pn * 256 + wc * 32 + 8 * fq;
#pragma unroll
        for (int ai = 0; ai < 2; ++ai)
#pragma unroll
            for (int m = 0; m < 4; ++m) { const int r = row0 + ai * 128 + m * 16;
                const float rstd = __builtin_amdgcn_rsqf(__hip_atomic_load(ss + r, __ATOMIC_RELAXED, __HIP_MEMORY_SCOPE_AGENT) * (1.0f / DM) + EPS);
                bf16_t* rowp = U + (size_t)r * DFF + col0;
#pragma unroll
                for (int bj = 0; bj < 2; ++bj) { f32x4 v0 = acc[ai][bj][m][0] * rstd, v1 = acc[ai][bj][m][1] * rstd;
#pragma unroll
                    for (int j = 0; j < 4; ++j) { const float a = fmaxf(v0[j], 0.f), b = fmaxf(v1[j], 0.f); v0[j] = a * a; v1[j] = b * b; }
                    u32x4 w; w.x = cvt_pk_bf16(v0[0], v0[1]); w.y = cvt_pk_bf16(v0[2], v0[3]); w.z = cvt_pk_bf16(v1[0], v1[1]); w.w = cvt_pk_bf16(v1[2], v1[3]);
                    *(u32x4*)(rowp + bj * 128) = w; } }
    }
};
struct EpiDown {
    float* X; float* ss;
    __device__ __forceinline__ int bkind(const Unit&) const { return 2; }
    __device__ __forceinline__ void operator()(const AccT& acc, const Unit& u, int wr, int wc, int fr, int fq) const {
        const int row0 = u.pm * 256 + wr * 64 + fr, col0 = u.pn * 256 + wc * 32 + 4 * fq;
#pragma unroll
        for (int ai = 0; ai < 2; ++ai)
#pragma unroll
            for (int m = 0; m < 4; ++m) { const int r = row0 + ai * 128 + m * 16; const size_t off = (size_t)r * DM + col0; float s = 0.f;
#pragma unroll
                for (int bj = 0; bj < 2; ++bj)
#pragma unroll
                    for (int n = 0; n < 2; ++n) { const f32x4 x = *(const f32x4*)(X + off + bj * 128 + n * 16); const f32x4 o = x + acc[ai][bj][m][n];
                        *(f32x4*)(X + off + bj * 128 + n * 16) = o; s += (o[0] * o[0] + o[1] * o[1]) + (o[2] * o[2] + o[3] * o[3]); }
                s += __shfl_xor(s, 16); s += __shfl_xor(s, 32);
                if (fq == 0) atomicAdd(ss + r, s); }
    }
};

#define XB_TMO      128
#define XB_XCNT(j)  (256  + 64 * (j))
#define XB_XSUB(j)  (1280 + 64 * (j))
#define XB_XGEN(j)  (2304 + 64 * (j))
#define XB_TOP      3328
#define XB_TOPGEN   3392
#define XCD_BAR_WORDS 3456
#define XB_SPIN_CAP (1u << 18)
__device__ __forceinline__ unsigned xb_ld(unsigned* p)              { return __hip_atomic_load(p, __ATOMIC_RELAXED, __HIP_MEMORY_SCOPE_AGENT); }
__device__ __forceinline__ unsigned xb_add(unsigned* p, unsigned v) { return __hip_atomic_fetch_add(p, v, __ATOMIC_RELAXED, __HIP_MEMORY_SCOPE_AGENT); }
__device__ __forceinline__ unsigned xb_xcc_id() { return (unsigned)__builtin_amdgcn_s_getreg((3 << 11) | 20) & 0xFu; }
#define XB_SPIN(cond, bar) do { unsigned _sp = 0; while (cond) { __builtin_amdgcn_s_sleep(1); \
    if ((++_sp & 255u) == 0u) { if (xb_ld(&(bar)[XB_TMO])) break; if (_sp > XB_SPIN_CAP) { atomicAdd(&(bar)[XB_TMO], 1u); break; } } } } while (0)
struct XcdBarrier { unsigned* bar; unsigned x; volatile LAS unsigned* st; };
__device__ __forceinline__ XcdBarrier xcd_barrier_post(unsigned* bar, volatile LAS unsigned* st) {
    XcdBarrier b; b.bar = bar; b.x = xb_xcc_id(); b.st = st;
    if (threadIdx.x == 0) (void)xb_add(&bar[XB_XCNT(b.x)], 1u);
    return b;
}
__device__ __forceinline__ void xcd_barrier_complete(unsigned* bar, unsigned x, unsigned& nloc, unsigned& nx) {
    const unsigned G = gridDim.x * gridDim.y * gridDim.z;
    unsigned sum, cnt, mine, sp = 0u;
    for (;;) {
        sum = 0u; cnt = 0u; mine = 0u;
#pragma unroll
        for (unsigned j = 0; j < 16; ++j) { const unsigned c = xb_ld(&bar[XB_XCNT(j)]); sum += c; cnt += (c > 0u) ? 1u : 0u; mine = (j == x) ? c : mine; }
        if (sum == G) break;
        __builtin_amdgcn_s_sleep(1);
        if ((++sp & 255u) == 0u) { if (xb_ld(&bar[XB_TMO])) break; if (sp > XB_SPIN_CAP) { atomicAdd(&bar[XB_TMO], 1u); break; } }
    }
    nloc = mine > 0u ? mine : 1u; nx = cnt > 0u ? cnt : 1u;
}
__device__ __forceinline__ void xcd_barrier(const XcdBarrier& b) {
    asm volatile("s_waitcnt vmcnt(0)" ::: "memory");
    __syncthreads();
    if (threadIdx.x == 0) {
        unsigned* bar = b.bar;
        __builtin_amdgcn_s_waitcnt(0);
        unsigned nloc = b.st[0], nx = b.st[1];
        if (nloc == 0u) { xcd_barrier_complete(bar, b.x, nloc, nx); b.st[0] = nloc; b.st[1] = nx; }
        const unsigned old = xb_add(&bar[XB_XSUB(b.x)], 1u);
        const unsigned gen = old / nloc;
        if (old + 1u == (gen + 1u) * nloc) {
            __builtin_amdgcn_fence(__ATOMIC_RELEASE, "agent");
            asm volatile("s_waitcnt vmcnt(0)" ::: "memory");
            const unsigned og = xb_add(&bar[XB_TOP], 1u);
            const unsigned tg = og / nx;
            if (og + 1u == (tg + 1u) * nx) xb_add(&bar[XB_TOPGEN], 1u);
            else XB_SPIN(xb_ld(&bar[XB_TOPGEN]) == tg, bar);
            __builtin_amdgcn_fence(__ATOMIC_ACQUIRE, "agent");
            xb_add(&bar[XB_XGEN(b.x)], 1u);
            asm volatile("s_waitcnt vmcnt(0)" ::: "memory");
        } else {
            XB_SPIN(xb_ld(&bar[XB_XGEN(b.x)]) == gen, bar);
            __builtin_amdgcn_fence(__ATOMIC_ACQUIRE, "agent");
            asm volatile("s_waitcnt vmcnt(0)" ::: "memory");
        }
    }
    __syncthreads();
}

constexpr int RING_BYTES = 131072;
constexpr int LDSCTL_OFF = RING_BYTES, MISC_OFF = LDSCTL_OFF + 320;
constexpr int LDS_BYTES = 147456;
constexpr int NWAVES = 8, NTHR = 512;

struct Params { const float* in[23]; float* out; unsigned char* ws; int ph_lo, ph_hi, li, pad; };
struct Ctx { LAS unsigned char* lds; int tid, lane, wave, vcu, G; };

__device__ __forceinline__ void p0_transpose_item(const float* W, int K, int N, bf16_t* WT, LAS float* scr, int item, int lane) {
    const int nblk = N / 32, kb = item / nblk, nb = item % nblk, k0 = 64 * kb, n0 = 32 * nb;
#pragma unroll 8
    for (int i = 0; i < 32; ++i) { const int kk = 2 * i + (lane >> 5); scr[kk * 33 + (lane & 31)] = W[(size_t)(k0 + kk) * N + n0 + (lane & 31)]; }
    LDS_WAIT(); asm volatile("" ::: "memory");
    const int c = lane & 7;
#pragma unroll
    for (int j = 0; j < 4; ++j) { const int n = (lane >> 3) + 8 * j; const LAS float* s = scr + (8 * c) * 33 + n;
        u32x4 o; o.x = pk2(s[0 * 33], s[1 * 33]); o.y = pk2(s[2 * 33], s[3 * 33]); o.z = pk2(s[4 * 33], s[5 * 33]); o.w = pk2(s[6 * 33], s[7 * 33]);
        *(u32x4*)(WT + (size_t)(n0 + n) * K + k0 + 8 * c) = o; }
    LDS_WAIT(); asm volatile("" ::: "memory");
}
__device__ __forceinline__ void rms_row_to_bf16(const float* xrow, const float* g, bf16_t* orow, int lane) {
    const f32x4* xr = (const f32x4*)xrow + lane; const f32x4* gr = (const f32x4*)g + lane;
    f32x4 v[8]; float s = 0.f;
#pragma unroll
    for (int j = 0; j < 8; ++j) { v[j] = xr[64 * j]; s += (v[j][0] * v[j][0] + v[j][1] * v[j][1]) + (v[j][2] * v[j][2] + v[j][3] * v[j][3]); }
    const float rstd = 1.0f / sqrtf(wave_sum(s) * (1.f / DM) + EPS);
    u32x2* o8 = (u32x2*)orow + lane;
#pragma unroll
    for (int j = 0; j < 8; ++j) { const f32x4 gg = gr[64 * j]; u32x2 w; w.x = pk2(v[j][0] * rstd * gg[0], v[j][1] * rstd * gg[1]); w.y = pk2(v[j][2] * rstd * gg[2], v[j][3] * rstd * gg[3]); o8[64 * j] = w; }
}
__device__ __forceinline__ void sincos_entry(int idx, float* COS, float* SIN) {
    const int tr = idx >> 6, i = idx & 63;
    const double pos = (tr < 2064) ? (double)tr : (double)(16384 + (tr - 2064));
    const double ang = pos * INVF[i];
    const double k = __builtin_rint(ang * 0.63661977236758134308);
    double y = __builtin_fma(-k, 1.57079632679489655800e+00, ang);
    y = __builtin_fma(-k, 6.12323399573676603587e-17, y);
    const double z = y * y;
    double sp = -7.6471637318198164759e-13;
    sp = sp * z + 1.6059043836821614599e-10;
    sp = sp * z - 2.5052108385441718775e-08;
    sp = sp * z + 2.7557319223985890653e-06;
    sp = sp * z - 1.9841269841269841270e-04;
    sp = sp * z + 8.3333333333333333333e-03;
    sp = sp * z - 1.6666666666666666667e-01;
    const double s = y + y * z * sp;
    double cp = 4.7794773323873852974e-14;
    cp = cp * z - 1.1470745597729724714e-11;
    cp = cp * z + 2.0876756987868098979e-09;
    cp = cp * z - 2.7557319223985890653e-07;
    cp = cp * z + 2.4801587301587301587e-05;
    cp = cp * z - 1.3888888888888888889e-03;
    cp = cp * z + 4.1666666666666666667e-02;
    cp = cp * z - 0.5;
    const double c = 1.0 + z * cp;
    const int q = ((int)(long long)k) & 3;
    const double sv = (q == 0) ? s : (q == 1) ? c : (q == 2) ? -s : -c;
    const double cv = (q == 0) ? c : (q == 1) ? -s : (q == 2) ? -c : s;
    COS[idx] = (float)cv; SIN[idx] = (float)sv;
}
__device__ __forceinline__ void p0_prep(const Ctx& C, const Params& P) {
    unsigned char* ws = P.ws;
    LAS float* scr = (LAS float*)(C.lds + C.wave * 16384);
    const int gw = C.vcu * NWAVES + C.wave, NGW = C.G * NWAVES;
    constexpr int I_IN = (DM / 64) * (DPROJ / 32), I_UP = (DM / 64) * (DFF / 32), I_DN = (DFF / 64) * (DM / 32), I_OUT = (DM / 64) * (DM / 32), I_PA = (LW / 64) * (DM / 32);
    constexpr int NITEMS = I_IN + I_UP + I_DN + I_OUT + 2 * I_PA;
    for (int it = gw; it < NITEMS; it += NGW) {
        int r = it;
        if (r < I_IN) { p0_transpose_item(P.in[7], DM, DPROJ, (bf16_t*)(ws + WS_WIN), scr, r, C.lane); continue; } r -= I_IN;
        if (r < I_UP) { p0_transpose_item(P.in[20], DM, DFF, (bf16_t*)(ws + WS_WUP), scr, r, C.lane); continue; } r -= I_UP;
        if (r < I_DN) { p0_transpose_item(P.in[21], DFF, DM, (bf16_t*)(ws + WS_WDN), scr, r, C.lane); continue; } r -= I_DN;
        if (r < I_OUT) { p0_transpose_item(P.in[18], DM, DM, (bf16_t*)(ws + WS_WOUT), scr, r, C.lane); continue; } r -= I_OUT;
        if (r < I_PA) { p0_transpose_item(P.in[16], LW, DM, (bf16_t*)(ws + WS_PA), scr, r, C.lane); continue; } r -= I_PA;
        p0_transpose_item(P.in[17], LW, DM, (bf16_t*)(ws + WS_PB), scr, r, C.lane);
    }
    bf16_t* H = (bf16_t*)(ws + WS_H);
    for (int m = gw; m < M1PAD; m += NGW) {
        bf16_t* orow = H + (size_t)m * DM;
        if (m < M1) {
            const float* xrow = (m < MP) ? P.in[0] + (size_t)m * DM : (m < M) ? P.in[1] + (size_t)(m - MP) * DM : P.in[5] + (size_t)(m - M) * DM;
            rms_row_to_bf16(xrow, P.in[6], orow, C.lane);
        } else {
            u32x2* o8 = (u32x2*)orow + C.lane;
#pragma unroll
            for (int j = 0; j < 8; ++j) o8[64 * j] = (u32x2){0u, 0u};
        }
    }
    float* COS = (float*)(ws + WS_TAB); float* SIN = COS + TABROWS * 64;
    const int gt = C.vcu * NTHR + C.tid, NGT = C.G * NTHR;
    for (int i = gt; i < TABROWS * 64; i += NGT) sincos_entry(i, COS, SIN);
    float* ss = (float*)(ws + WS_SS);
    for (int i = gt; i < 2 * M; i += NGT) ss[i] = 0.f;
}

__device__ __forceinline__ void p2_gates_simple(const Ctx& C, const Params& P, float* Aarr, float* Barr) {
    unsigned char* ws = P.ws;
    const bf16_t* XA = (const bf16_t*)(ws + WS_XA);
    float* metaA = (float*)(ws + WS_METAAB); float* metaB = metaA + NMETA * LW;
    const float* state_conv = P.in[2]; const float* conv_w = P.in[8]; const float* conv_b = P.in[9];
    const float* wa = P.in[10]; const float* ba = P.in[11]; const float* wx = P.in[12]; const float* bx = P.in[13]; const float* lam = P.in[14];
    LAS float* xcs = (LAS float*)C.lds;
    const int rl = C.tid >> 6, d = C.tid & 63;
    constexpr int NRG = M1 / 8;
    for (int item = C.vcu; item < NRG * NBLK; item += C.G) {
        const int n = item / NRG, rg = item % NRG;
        const int row = rg * 8 + rl, ch = n * 64 + d;
        float xc = conv_b[ch];
#pragma unroll
        for (int j = 0; j < 4; ++j) {
            float val;
            if (row < MP) { const int b = row >> 11, t = row & 2047, tt = t - 3 + j; val = bf2f(XA[(size_t)(tt >= 0 ? (b * 2048 + tt) : (MROW_META + 16 + tt)) * LW + ch]); }
            else if (row < M) { const int s = row - MP, b = s >> 3, t = s & 7, tt = t - 3 + j; val = (tt >= 0) ? bf2f(XA[(size_t)(MP + b * 8 + tt) * LW + ch]) : state_conv[((size_t)b * 3 + (3 + tt)) * LW + ch]; }
            else { const int t = row - M, tt = t - 3 + j; val = (tt >= 0) ? bf2f(XA[(size_t)(MROW_META + tt) * LW + ch]) : 0.f; }
            xc += conv_w[j * LW + ch] * val;
        }
        xcs[rl * 64 + d] = xc;
        __syncthreads();
        float rp = ba[ch], ip = bx[ch];
        const float* wan = wa + (size_t)n * 4096 + d; const float* wxn = wx + (size_t)n * 4096 + d;
#pragma unroll 8
        for (int c = 0; c < 64; ++c) { const float x = xcs[rl * 64 + c]; rp += x * wan[c * 64]; ip += x * wxn[c * 64]; }
        const float r = 1.0f / (1.0f + __expf(-rp)), ig = 1.0f / (1.0f + __expf(-ip));
        const float e = __expf(-lam[ch]);
        const float L = -8.0f * (e * (1.0f - e * (0.5f - e * (0.33333333f - 0.25f * e))));
        const float a = __expf(r * L);
        float mult = sqrtf(fmaxf(1.0f - a * a, 0.f));
        if (row == MROW_META) mult = 1.0f;
        const float bt = mult * ig * xc;
        if (row < M) { Aarr[(size_t)row * LW + ch] = a; Barr[(size_t)row * LW + ch] = bt; }
        else { metaA[(row - M) * LW + ch] = a; metaB[(row - M) * LW + ch] = bt; }
        __syncthreads();
    }
}
__device__ __forceinline__ void p2_scan_simple(const Ctx& C, const Params& P, const float* Aarr, const float* Barr) {
    unsigned char* ws = P.ws;
    const bf16_t* XA = (const bf16_t*)(ws + WS_XA); const bf16_t* GA = (const bf16_t*)(ws + WS_GA); bf16_t* YA = (bf16_t*)(ws + WS_YA);
    const float* metaA = (const float*)(ws + WS_METAAB); const float* metaB = metaA + NMETA * LW;
    float* out = P.out;
    const int gt = C.vcu * NTHR + C.tid, NGT = C.G * NTHR;
    for (int i = gt; i < (NB + DECB) * LW; i += NGT) {
        const int s = i >> 10, ch = i & 1023;
        if (s < NB) {
            float h = 0.f;
            for (int t = 0; t < NMETA; ++t) h = metaA[t * LW + ch] * h + metaB[t * LW + ch];
            const size_t base = (size_t)s * SEQ * LW + ch;
#pragma unroll 8
            for (int t = 0; t < SEQ; ++t) { const size_t o = base + (size_t)t * LW; h = Aarr[o] * h + Barr[o]; YA[o] = (bf16_t)f2bf(h * bf2f(GA[o])); }
            out[O_NLP + s * LW + ch] = h;
#pragma unroll
            for (int j = 0; j < 3; ++j) out[O_NCP + ((size_t)s * 3 + j) * LW + ch] = bf2f(XA[base + (size_t)(SEQ - 3 + j) * LW]);
        } else {
            const int b = s - NB;
            float h = P.in[3][b * LW + ch];
            const size_t base = (size_t)(MP + b * 8) * LW + ch;
#pragma unroll
            for (int t = 0; t < DECS; ++t) { const size_t o = base + (size_t)t * LW; h = Aarr[o] * h + Barr[o]; YA[o] = (bf16_t)f2bf(h * bf2f(GA[o])); }
            out[O_NLS + b * LW + ch] = h;
#pragma unroll
            for (int j = 0; j < 3; ++j) out[O_NCS + ((size_t)b * 3 + j) * LW + ch] = bf2f(XA[base + (size_t)(DECS - 3 + j) * LW]);
        }
    }
}
__device__ __forceinline__ void p2_ret_simple(const Ctx& C, const Params& P) {
    unsigned char* ws = P.ws;
    const bf16_t* Q = (const bf16_t*)(ws + WS_Q); const bf16_t* K = (const bf16_t*)(ws + WS_K); const bf16_t* V = (const bf16_t*)(ws + WS_V); const bf16_t* G = (const bf16_t*)(ws + WS_G);
    bf16_t* YB = (bf16_t*)(ws + WS_YB);
    const float* gn = P.in[15]; const float* S0 = P.in[4]; float* out = P.out;
    LAS float* qs = (LAS float*)C.lds;
    LAS float* ks = qs + 2048; LAS float* vs = ks + 2048;
    LAS float* red = vs + 2048;
    LAS float* st = red + 8192;
    const int v = C.tid & 127, dq = C.tid >> 7;
    for (int item = C.vcu; item < (NB + DECB) * RH; item += C.G) {
        const int s = item >> 3, h = item & 7;
        const bool prompt = s < NB;
        const float lg = lg2gamma(h);
        float Z[32];
        if (prompt) {
#pragma unroll
            for (int j = 0; j < 32; ++j) Z[j] = 0.f;
        } else {
            const float* sp = S0 + (((size_t)(s - NB) * RH + h) * DK + dq * 32) * 128 + v;
#pragma unroll
            for (int j = 0; j < 32; ++j) Z[j] = sp[(size_t)j * 128];
        }
        const int nbatch = prompt ? 129 : 1;
        for (int bi = 0; bi < nbatch; ++bi) {
            const int ntok = prompt ? 16 : 8;
            const int rowb = prompt ? (bi == 0 ? MROW_META : s * SEQ + (bi - 1) * 16) : MP + (s - NB) * 8;
            __syncthreads();
            for (int idx = C.tid; idx < 3 * ntok * 128; idx += NTHR) {
                const int arr = idx / (ntok * 128), rem = idx % (ntok * 128), tok = rem >> 7, e = rem & 127;
                const bf16_t* src = (arr == 0) ? Q : (arr == 1) ? K : V;
                const float val = bf2f(src[(size_t)(rowb + tok) * 1024 + h * 128 + e]);
                ((arr == 0) ? qs : (arr == 1) ? ks : vs)[tok * 128 + e] = val;
            }
            __syncthreads();
            for (int tok = 0; tok < ntok; ++tok) {
                const float vv = vs[tok * 128 + v]; float part = 0.f;
#pragma unroll
                for (int j = 0; j < 32; ++j) { Z[j] = fmaf(ks[tok * 128 + dq * 32 + j], vv, Z[j]); part = fmaf(qs[tok * 128 + dq * 32 + j], Z[j], part); }
                red[(tok * 4 + dq) * 128 + v] = part;
            }
            __syncthreads();
            const int per = ntok >> 2;
            float o[4];
#pragma unroll
            for (int i = 0; i < 4; ++i) { o[i] = 0.f; if (i < per) { const int tok = dq * per + i; o[i] = (red[(tok * 4 + 0) * 128 + v] + red[(tok * 4 + 1) * 128 + v]) + (red[(tok * 4 + 2) * 128 + v] + red[(tok * 4 + 3) * 128 + v]);
                    const float s1 = wave_sum(o[i]), s2 = wave_sum(o[i] * o[i]);
                    if (C.lane == 0) { st[(tok * 2 + (C.wave & 1)) * 2 + 0] = s1; st[(tok * 2 + (C.wave & 1)) * 2 + 1] = s2; } } }
            __syncthreads();
            const bool want_y = !(prompt && bi == 0);
#pragma unroll
            for (int i = 0; i < 4; ++i) if (i < per && want_y) { const int tok = dq * per + i;
                    const float mu = (st[(tok * 2 + 0) * 2 + 0] + st[(tok * 2 + 1) * 2 + 0]) * (1.f / 128.f);
                    const float var = (st[(tok * 2 + 0) * 2 + 1] + st[(tok * 2 + 1) * 2 + 1]) * (1.f / 128.f) - mu * mu;
                    const float y = (o[i] - mu) * (1.0f / sqrtf(fmaxf(var, 0.f) + EPS)) * gn[h * 128 + v];
                    const size_t off = (size_t)(rowb + tok) * 1024 + h * 128 + v;
                    YB[off] = (bf16_t)f2bf(y * bf2f(G[off])); }
            float sc = 1.f;
            if (!prompt) sc = __builtin_amdgcn_exp2f(8.f * lg);
            else if (bi == 0) sc = __builtin_amdgcn_exp2f(16.f * lg);
            else if ((bi & 7) == 0) sc = __builtin_amdgcn_exp2f(128.f * lg);
            if (sc != 1.f) {
#pragma unroll
                for (int j = 0; j < 32; ++j) Z[j] *= sc; }
        }
        float* dst = prompt ? out + O_NRP + (((size_t)s * RH + h) * DK + dq * 32) * 128 + v : out + O_NRS + (((size_t)(s - NB) * RH + h) * DK + dq * 32) * 128 + v;
#pragma unroll
        for (int j = 0; j < 32; ++j) dst[(size_t)j * 128] = Z[j];
    }
}
__device__ __forceinline__ void p7_final_norm(const Ctx& C, const Params& P) {
    const float* ss2 = (const float*)(P.ws + WS_SS) + M; const float* gf = P.in[22];
    const int gw = C.vcu * NWAVES + C.wave, NGW = C.G * NWAVES;
    for (int m = gw; m < M; m += NGW) {
        const float rstd = 1.0f / sqrtf(__hip_atomic_load(ss2 + m, __ATOMIC_RELAXED, __HIP_MEMORY_SCOPE_AGENT) * (1.f / DM) + EPS);
        f32x4* xr = (f32x4*)(P.out + (size_t)m * DM) + C.lane; const f32x4* gr = (const f32x4*)gf + C.lane;
#pragma unroll
        for (int j = 0; j < 8; ++j) { f32x4 x = xr[64 * j]; x = x * rstd * gr[64 * j]; xr[64 * j] = x; }
    }
}

constexpr int NPHASE = 10;
__global__ void __launch_bounds__(NTHR, 2) mega_fwd(Params P) {
    extern __shared__ __attribute__((aligned(16))) unsigned char lds_raw[];
    Ctx C;
    C.lds = (LAS unsigned char*)lds_raw;
    C.tid = threadIdx.x; C.lane = C.tid & 63; C.wave = __builtin_amdgcn_readfirstlane(C.tid >> 6);
    C.G = gridDim.x; { const int bx = blockIdx.x; C.vcu = (C.G % 8 == 0) ? (bx % 8) * (C.G / 8) + bx / 8 : bx; }
    volatile LAS unsigned* MISC = (volatile LAS unsigned*)(C.lds + MISC_OFF);
    for (int u = C.tid; u < (LDS_BYTES - LDSCTL_OFF) / 4; u += NTHR) ((LAS unsigned*)(C.lds + LDSCTL_OFF))[u] = 0u;
    __syncthreads();
    unsigned char* ws = P.ws;
    XcdBarrier bar; bar.bar = (unsigned*)(ws + WS_CTL) + CW_BAR; bar.x = 0; bar.st = nullptr;
    const bool one_launch = (P.ph_hi - P.ph_lo) > 1;
    if (one_launch) bar = xcd_barrier_post((unsigned*)(ws + WS_CTL) + CW_BAR, MISC + 8);
    const int lo = P.ph_lo, hi = P.ph_hi;
#define IN(k) (lo <= (k) && (k) < hi)
#define SEAM(k) do { if (IN(k) && IN((k) + 1)) xcd_barrier(bar); } while (0)
    float* Aarr = P.out; float* Barr = P.out + (size_t)M * LW;
    float* T = P.out;
    if (IN(0)) { p0_prep(C, P); } SEAM(0);
    if (IN(1)) {
        pg8::TileOrder S; S.init(37, 40, C.G, (int)blockIdx.x);
        EpiProj E{(bf16_t*)(ws + WS_XA), (bf16_t*)(ws + WS_GA), (bf16_t*)(ws + WS_Q), (bf16_t*)(ws + WS_K), (bf16_t*)(ws + WS_V), (bf16_t*)(ws + WS_G), (bf16_t*)(ws + WS_SA), (bf16_t*)(ws + WS_SB),
                  (const float*)(ws + WS_TAB), (const float*)(ws + WS_TAB) + TABROWS * 64};
        pg8::gemm_phase<EpiProj, true, true>(C.lds, (const bf16_t*)(ws + WS_H), (const bf16_t*)(ws + WS_WIN), DM, S, E);
    } SEAM(1);
    if (IN(2)) { p2_gates_simple(C, P, Aarr, Barr); } SEAM(2);
    if (IN(3)) { p2_scan_simple(C, P, Aarr, Barr); p2_ret_simple(C, P); } SEAM(3);
    if (IN(4)) {
        pg8::TileOrder S; S.init(36, 8, C.G, (int)blockIdx.x);
        EpiMergeA E{(const bf16_t*)(ws + WS_SA), T};
        pg8::gemm_phase<EpiMergeA, true, true>(C.lds, (const bf16_t*)(ws + WS_YA), (const bf16_t*)(ws + WS_PA), LW, S, E);
    } SEAM(4);
    if (IN(5)) {
        pg8::TileOrder S; S.init(36, 8, C.G, (int)blockIdx.x);
        EpiMergeB E{(const bf16_t*)(ws + WS_SB), T, (bf16_t*)(ws + WS_MERGED)};
        pg8::gemm_phase<EpiMergeB, true, true>(C.lds, (const bf16_t*)(ws + WS_YB), (const bf16_t*)(ws + WS_PB), LW, S, E);
    } SEAM(5);
    if (IN(6)) {
        pg8::TileOrder S; S.init(36, 8, C.G, (int)blockIdx.x);
        EpiRes1 E{P.in[0], P.in[1], P.out, (bf16_t*)(ws + WS_X1N), P.in[19], (float*)(ws + WS_SS)};
        pg8::gemm_phase<EpiRes1, true, true>(C.lds, (const bf16_t*)(ws + WS_MERGED), (const bf16_t*)(ws + WS_WOUT), DM, S, E);
    } SEAM(6);
    if (IN(7)) {
        pg8::TileOrder S; S.init(36, 32, C.G, (int)blockIdx.x);
        EpiUp E{(const float*)(ws + WS_SS), (bf16_t*)(ws + WS_U)};
        pg8::gemm_phase<EpiUp, true, true>(C.lds, (const bf16_t*)(ws + WS_X1N), (const bf16_t*)(ws + WS_WUP), DM, S, E);
    } SEAM(7);
    if (IN(8)) {
        pg8::TileOrder S; S.init(36, 8, C.G, (int)blockIdx.x);
        EpiDown E{P.out, (float*)(ws + WS_SS) + M};
        pg8::gemm_phase<EpiDown, true, true>(C.lds, (const bf16_t*)(ws + WS_U), (const bf16_t*)(ws + WS_WDN), DFF, S, E);
    } SEAM(8);
    if (IN(9)) { p7_final_norm(C, P); }
#undef IN
#undef SEAM
}

extern "C" void kernel_launch(void* const* d_in, const int* in_sizes, int n_in, void* d_out, int out_size, void* d_ws, size_t ws_size, hipStream_t stream) {
    static int grid = 0;
    if (grid == 0) {
        if (n_in != 23 || (size_t)out_size != O_END || ws_size < WS_END) { fprintf(stderr, "kernel_launch: unexpected sizes n_in %d out %d ws %zu (need %zu)\n", n_in, out_size, ws_size, (size_t)WS_END); grid = -1; return; }
        int dev = 0, cus = 0, per_cu = 0;
        if (hipGetDevice(&dev) != hipSuccess || hipDeviceGetAttribute(&cus, hipDeviceAttributeMultiprocessorCount, dev) != hipSuccess) { grid = -1; return; }
        if (hipFuncSetAttribute((const void*)mega_fwd, hipFuncAttributeMaxDynamicSharedMemorySize, LDS_BYTES) != hipSuccess) { fprintf(stderr, "kernel_launch: hipFuncSetAttribute failed\n"); grid = -1; return; }
        if (hipOccupancyMaxActiveBlocksPerMultiprocessor(&per_cu, (const void*)mega_fwd, NTHR, LDS_BYTES) != hipSuccess || per_cu < 1) { fprintf(stderr, "kernel_launch: occupancy query says %d blocks per CU\n", per_cu); (void)hipGetLastError(); grid = -1; return; }
        grid = cus;
    }
    if (grid < 0) return;
    if (hipMemsetAsync((char*)d_ws + WS_CTL, 0, CTL_ZERO_BYTES, stream) != hipSuccess) return;
    Params a{};
    for (int i = 0; i < 23; ++i) a.in[i] = (const float*)d_in[i];
    a.out = (float*)d_out; a.ws = (unsigned char*)d_ws;
#if MK_N_LAUNCHES == 1
    a.ph_lo = 0; a.ph_hi = NPHASE; a.li = 0;
    hipLaunchKernelGGL(mega_fwd, dim3(grid), dim3(NTHR), LDS_BYTES, stream, a);
#else
    for (int li = 0; li < NPHASE; ++li) { a.ph_lo = li; a.ph_hi = li + 1; a.li = li; hipLaunchKernelGGL(mega_fwd, dim3(grid), dim3(NTHR), LDS_BYTES, stream, a); }
#endif
}
```

```cpp
#include <hip/hip_runtime.h>
#include <cstdio>
#include <cstdint>

#ifndef MK_N_LAUNCHES
#define MK_N_LAUNCHES 1
#endif

#define LAS __attribute__((address_space(3)))
#define GAS __attribute__((address_space(1)))
typedef unsigned short bf16_t;
typedef short bf16x8 __attribute__((ext_vector_type(8)));
typedef float f32x4 __attribute__((ext_vector_type(4)));
typedef float f32x2 __attribute__((ext_vector_type(2)));
typedef unsigned u32x4 __attribute__((ext_vector_type(4)));
typedef unsigned u32x2 __attribute__((ext_vector_type(2)));
typedef GAS unsigned gu32;

constexpr int DM = 2048, NB = 4, SEQ = 2048, DECB = 128, DECS = 8, NMETA = 16;
constexpr int LW = 1024, NBLK = 16, BLK = 64, RH = 8, DK = 128, DFF = 8192, DPROJ = 10240;
constexpr int MP = NB * SEQ;
constexpr int MS = DECB * DECS;
constexpr int M = MP + MS;
constexpr int MROW_META = M;
constexpr int M1 = M + NMETA;
constexpr int M1PAD = 9472;
constexpr float EPS = 1e-6f;
constexpr int TABROWS = 2064 + 8;

constexpr size_t O_YP = 0, O_YS = 16777216, O_NCP = 18874368, O_NLP = 18886656, O_NRP = 18890752, O_NCS = 19415040, O_NLS = 19808256, O_NRS = 19939328, O_END = 36716544;

constexpr size_t MiB = 1u << 20;
constexpr size_t WS_CTL = 0, CTL_ZERO_BYTES = 1 * MiB;
constexpr size_t WS_TAB = 1 * MiB;
constexpr size_t WS_SS = 3 * MiB;
constexpr size_t WS_METAAB = 3 * MiB + 256 * 1024;
constexpr size_t WS_LRUW = 3 * MiB + 512 * 1024;
constexpr size_t WS_SUMM = 2 * MiB + 256 * 1024;
constexpr size_t WS_SUMMETA = WS_SUMM + 512 * 1024;
constexpr size_t WS_WIN = 4 * MiB;
constexpr size_t WS_WUP = 44 * MiB, WS_WDN = 76 * MiB, WS_WOUT = 108 * MiB, WS_PA = 116 * MiB, WS_PB = 120 * MiB;
constexpr size_t WS_H = 124 * MiB;
constexpr size_t WS_XA = 161 * MiB;
constexpr size_t SZ_P1 = (size_t)M1PAD * 1024 * 2;
constexpr size_t WS_GA = WS_XA + SZ_P1, WS_Q = WS_GA + SZ_P1, WS_K = WS_Q + SZ_P1, WS_V = WS_K + SZ_P1, WS_G = WS_V + SZ_P1, WS_SA = WS_G + SZ_P1, WS_SB = WS_SA + 2 * SZ_P1;
constexpr size_t WS_END = WS_SB + 2 * SZ_P1;
constexpr size_t WS_YA = WS_WIN, WS_YB = WS_WIN + (size_t)M * 1024 * 2, WS_X1N = WS_WIN, WS_MERGED = WS_H, WS_U = WS_XA;
static_assert(WS_END == 346 * MiB, "ws map");
static_assert(WS_U + (size_t)M * DFF * 2 <= WS_END, "u overlay");
constexpr int CW_BAR = 4096;

__device__ __forceinline__ float bf2f(unsigned b) { return __uint_as_float(b << 16); }
__device__ __forceinline__ unsigned f2bf(float f) { unsigned u = __float_as_uint(f); return (u + 0x7fffu + ((u >> 16) & 1u)) >> 16; }
__device__ __forceinline__ unsigned pk2(float lo, float hi) { return f2bf(lo) | (f2bf(hi) << 16); }
__device__ __forceinline__ unsigned cvt_pk_bf16(float lo, float hi) { unsigned r; asm volatile("v_cvt_pk_bf16_f32 %0, %1, %2" : "=v"(r) : "v"(lo), "v"(hi)); return r; }
__device__ __forceinline__ float fast_sigmoid(float x) { return __builtin_amdgcn_rcpf(1.0f + __builtin_amdgcn_exp2f(-1.4426950409f * x)); }
__device__ __forceinline__ float gelu_tanh(float x) { const float u = 1.5957691216f * (x + 0.044715f * x * x * x); return x * fast_sigmoid(u); }
__device__ __forceinline__ float silu_f(float x) { return x * fast_sigmoid(x); }
__device__ __forceinline__ float wave_sum(float v) {
#pragma unroll
    for (int o = 1; o < 64; o <<= 1) v += __shfl_xor(v, o);
    return v;
}
#define LDS_WAIT() asm volatile("s_waitcnt lgkmcnt(0)" ::: "memory")
#define VM_WAIT() asm volatile("s_waitcnt vmcnt(0)" ::: "memory")

__device__ const double INVF[64] = {1.0, 0.8659643233600653, 0.7498942093324559, 0.6493816315762113, 0.5623413251903491, 0.4869675251658631, 0.4216965034285822, 0.3651741272548377, 0.31622776601683794, 0.27384196342643613, 0.23713737056616552, 0.2053525026457146, 0.1778279410038923, 0.1539926526059492, 0.1333521432163324, 0.11547819846894582, 0.1, 0.08659643233600653, 0.07498942093324558, 0.06493816315762113, 0.05623413251903491, 0.04869675251658631, 0.042169650342858224, 0.03651741272548377, 0.03162277660168379, 0.027384196342643614, 0.023713737056616554, 0.02053525026457146, 0.01778279410038923, 0.01539926526059492, 0.01333521432163324, 0.011547819846894581, 0.01, 0.008659643233600654, 0.007498942093324558, 0.006493816315762113, 0.005623413251903491, 0.004869675251658631, 0.004216965034285823, 0.003651741272548377, 0.0031622776601683794, 0.0027384196342643613, 0.0023713737056616554, 0.002053525026457146, 0.0017782794100389228, 0.001539926526059492, 0.001333521432163324, 0.0011547819846894581, 0.001, 0.0008659643233600654, 0.0007498942093324559, 0.0006493816315762113, 0.0005623413251903491, 0.0004869675251658631, 0.00042169650342858224, 0.0003651741272548377, 0.00031622776601683794, 0.0002738419634264361, 0.00023713737056616554, 0.0002053525026457146, 0.00017782794100389227, 0.0001539926526059492, 0.0001333521432163324, 0.00011547819846894582};
__device__ __forceinline__ float lg2gamma(int h) {
    const float t[8] = {-0.04580368961312479f, -0.02272007650008353f, -0.011315313227834146f, -0.005646563141142063f, -0.0028205190623786626f, -0.0014095702546713536f, -0.0007046129765893727f, -0.0003522634716290214f};
    float r = t[0];
#pragma unroll
    for (int i = 1; i < 8; ++i) r = (h == i) ? t[i] : r;
    return r;
}

namespace pg8 {
constexpr int BM = 256, BK = 64, HALF = 128, HTB = HALF * BK * 2, STAGE_BYTES = 8 * HTB, NXCD = 8, WGM = 8;
__device__ __forceinline__ int lds_byte(int r, int c) { const int st = (r >> 4) * 2 + (c >> 5), rr = r & 15, cc = c & 31, ob = rr * 64 + cc * 2; return st * 1024 + (ob ^ (((ob >> 9) & 1) << 5)); }
__device__ __forceinline__ void stage_rc(int b, int& R, int& C) { const int st = b / 1024, sb = b % 1024, swz = sb ^ (((sb >> 9) & 1) << 5); R = (st >> 1) * 16 + swz / 64; C = (st & 1) * 32 + (swz % 64) / 2; }
__device__ __forceinline__ int perm32(int rho) { const int n = rho >> 4, i = rho & 15; return 8 * (i >> 2) + 4 * n + (i & 3); }
__device__ __forceinline__ int brow_perm(int R, int kind) {
    if (kind == 0) return (R & ~31) + perm32(R & 31);
    if (kind == 1) return ((R >> 5) << 4) + (R & 15) + (((R >> 4) & 1) << 6);
    return R;
}
struct Unit { int pm, pn; };
struct TileOrder {
    int nM, nN, nwg, G, c;
    __device__ void init(int nM_, int nN_, int G_, int c_) { nM = nM_; nN = nN_; nwg = nM * nN; G = G_; c = c_; }
    __device__ bool next(int i, Unit& u) const {
        const long L = (long)i * G + c; if (L >= nwg) return false;
        int wgid = (int)L; { const int q = nwg / NXCD, r = nwg % NXCD, xcd = wgid % NXCD, off = wgid / NXCD; wgid = (xcd < r ? xcd * (q + 1) : r * (q + 1) + (xcd - r) * q) + off; }
        const int nig = WGM * nN, gid = wgid / nig, fm = gid * WGM, gsz = (nM - fm) < WGM ? (nM - fm) : WGM;
        u.pm = fm + ((wgid % nig) % gsz); u.pn = (wgid % nig) / gsz; return true;
    }
};

template <class Epi, bool ALIGN_EPI, bool SP2>
__device__ __forceinline__ void gemm_phase(LAS unsigned char* lds, const bf16_t* Ag, const bf16_t* Btg, const int K, const TileOrder& S, const Epi& E) {
    const int tid = threadIdx.x, wid = __builtin_amdgcn_readfirstlane(tid >> 6), lane = tid & 63, wr = wid >> 2, wc = wid & 3, fr = lane & 15, fq = lane >> 4;
    const int nt = K / BK;
    int sR[2], sC[2];
    unsigned voffA[2], vBc[2], vBn[2];
#pragma unroll
    for (int i = 0; i < 2; ++i) { stage_rc(tid * 16 + i * 8192, sR[i], sC[i]); voffA[i] = (unsigned)(sR[i] * K + sC[i]) * 2u; }
    const size_t kstep = (size_t)(BK * 2);
    const size_t hstep = (size_t)HALF * K * 2;
    const size_t tstep = 2 * hstep;
    const unsigned ldsw = (unsigned)wid * 1024u;
    const int aoff = lds_byte(wr * 64 + fr, fq * 8), boff = lds_byte(wc * 32 + fr, fq * 8);
#define PG8_SA(b, h) (((b) * 2 + (h)) * HTB)
#define PG8_SB(b, h) ((4 + (b) * 2 + (h)) * HTB)
#define PG8_STAGE(bufoff, gbase, voff) do { _Pragma("unroll") for (int _i = 0; _i < 2; ++_i) \
        __builtin_amdgcn_global_load_lds((const unsigned*)((const char*)(gbase) + (voff)[_i]), (LAS unsigned*)(lds + (bufoff) + ldsw + _i * 8192), 16, 0, 0); } while (0)
#define PG8_LDA(dst, b, h) do { _Pragma("unroll") for (int m = 0; m < 4; ++m) _Pragma("unroll") for (int k = 0; k < 2; ++k) dst[m][k] = *(const LAS bf16x8*)(lds + PG8_SA(b, h) + aoff + m * 2048 + k * 1024); } while (0)
#define PG8_LDB(dst, b, h) do { _Pragma("unroll") for (int n = 0; n < 2; ++n) _Pragma("unroll") for (int k = 0; k < 2; ++k) dst[n][k] = *(const LAS bf16x8*)(lds + PG8_SB(b, h) + boff + n * 2048 + k * 1024); } while (0)
#define PG8_MMA(ai, bj, At, Bt) do { __builtin_amdgcn_s_setprio(1); _Pragma("unroll") for (int m = 0; m < 4; ++m) _Pragma("unroll") for (int n = 0; n < 2; ++n) _Pragma("unroll") for (int k = 0; k < 2; ++k) \
        acc[ai][bj][m][n] = __builtin_amdgcn_mfma_f32_16x16x32_bf16(Bt[n][k], At[m][k], acc[ai][bj][m][n], 0, 0, 0); __builtin_amdgcn_s_setprio(0); } while (0)
#define PG8_WAIT_V(n) asm volatile("s_waitcnt vmcnt(" #n ")" ::: "memory")
#define PG8_WAIT_L(n) asm volatile("s_waitcnt lgkmcnt(" #n ")" ::: "memory")
#define PG8_BAR __builtin_amdgcn_s_barrier()
#define PG8_SCHED __builtin_amdgcn_sched_barrier(0)
    Unit cur, nxt; int ui = 0;
    if (!S.next(0, cur)) return;
    { const int kind = E.bkind(cur);
#pragma unroll
      for (int i = 0; i < 2; ++i) { vBc[i] = (unsigned)(brow_perm(sR[i], kind) * K + sC[i]) * 2u; vBn[i] = vBc[i]; } }
    f32x4 acc[2][2][4][2];
#pragma unroll
    for (int a = 0; a < 2; ++a)
#pragma unroll
        for (int b = 0; b < 2; ++b)
#pragma unroll
            for (int m = 0; m < 4; ++m)
#pragma unroll
                for (int n = 0; n < 2; ++n) acc[a][b][m][n] = (f32x4){0.f, 0.f, 0.f, 0.f};
    bf16x8 At[4][2], B0[2][2], B1[2][2];
    const char* cA = (const char*)Ag + (size_t)cur.pm * tstep; const char* cB = (const char*)Btg + (size_t)cur.pn * tstep;
    if constexpr (SP2) {
        PG8_STAGE(PG8_SB(0, 0), cB, vBc); PG8_STAGE(PG8_SB(0, 1), cB + hstep, vBc); PG8_STAGE(PG8_SA(0, 0), cA, voffA); PG8_STAGE(PG8_SA(0, 1), cA + hstep, voffA);
        if (wr == 1) PG8_BAR;
        PG8_WAIT_V(2); PG8_BAR;
        PG8_STAGE(PG8_SB(1, 0), cB + kstep, vBc); PG8_STAGE(PG8_SA(1, 0), cA + kstep, voffA); PG8_STAGE(PG8_SB(1, 1), cB + hstep + kstep, vBc);
        PG8_WAIT_V(6); PG8_BAR;
    } else {
        PG8_STAGE(PG8_SB(0, 0), cB, vBc); PG8_STAGE(PG8_SA(0, 0), cA, voffA); PG8_STAGE(PG8_SB(0, 1), cB + hstep, vBc); PG8_STAGE(PG8_SA(0, 1), cA + hstep, voffA);
        if (wr == 1) PG8_BAR;
        PG8_WAIT_V(4); PG8_BAR;
        PG8_STAGE(PG8_SB(1, 0), cB + kstep, vBc); PG8_STAGE(PG8_SA(1, 0), cA + kstep, voffA); PG8_STAGE(PG8_SB(1, 1), cB + hstep + kstep, vBc);
        PG8_WAIT_V(6); PG8_BAR;
    }
    for (;;) {
        const bool has_next = S.next(ui + 1, nxt);
        const char* nA = has_next ? (const char*)Ag + (size_t)nxt.pm * tstep : cA; const char* nB = has_next ? (const char*)Btg + (size_t)nxt.pn * tstep : cB;
        if (has_next) { const int kind = E.bkind(nxt);
#pragma unroll
            for (int i = 0; i < 2; ++i) vBn[i] = (unsigned)(brow_perm(sR[i], kind) * K + sC[i]) * 2u; }
        for (int t = 0; t < nt; t += 2) {
            const bool last = (t == nt - 2);
            const char* a1 = cA + (size_t)(t + 1) * kstep;
            const char* a2 = last ? nA : cA + (size_t)(t + 2) * kstep; const char* b2 = last ? nB : cB + (size_t)(t + 2) * kstep;
            const char* a3 = a2 + kstep; const char* b3 = b2 + kstep;
            unsigned vB[2]; vB[0] = last ? vBn[0] : vBc[0]; vB[1] = last ? vBn[1] : vBc[1];
            if constexpr (SP2) {
            PG8_LDB(B0, 0, 0); PG8_LDB(B1, 0, 1); PG8_SCHED; PG8_LDA(At, 0, 0); PG8_STAGE(PG8_SA(1, 1), a1 + hstep, voffA);
            PG8_WAIT_V(8); PG8_WAIT_L(0); PG8_BAR; PG8_MMA(0, 0, At, B0); PG8_MMA(0, 1, At, B1); PG8_BAR; PG8_SCHED;
            PG8_LDA(At, 0, 1); PG8_STAGE(PG8_SB(0, 0), b2, vB); PG8_STAGE(PG8_SB(0, 1), b2 + hstep, vB); PG8_STAGE(PG8_SA(0, 0), a2, voffA);
            PG8_WAIT_V(8); PG8_WAIT_L(0); PG8_BAR; PG8_MMA(1, 0, At, B0); PG8_MMA(1, 1, At, B1); PG8_BAR; PG8_SCHED;
            PG8_LDB(B0, 1, 0); PG8_LDB(B1, 1, 1); PG8_SCHED; PG8_LDA(At, 1, 0); PG8_STAGE(PG8_SA(0, 1), a2 + hstep, voffA);
            PG8_WAIT_V(8); PG8_WAIT_L(0); PG8_BAR; PG8_MMA(0, 0, At, B0); PG8_MMA(0, 1, At, B1); PG8_BAR; PG8_SCHED;
            PG8_LDA(At, 1, 1); PG8_STAGE(PG8_SB(1, 0), b3, vB); PG8_STAGE(PG8_SB(1, 1), b3 + hstep, vB); PG8_STAGE(PG8_SA(1, 0), a3, voffA);
            PG8_WAIT_V(8); PG8_WAIT_L(0); PG8_BAR; PG8_MMA(1, 0, At, B0); PG8_MMA(1, 1, At, B1); PG8_BAR; PG8_SCHED;
            } else {
            PG8_LDB(B0, 0, 0); PG8_SCHED; PG8_LDA(At, 0, 0); PG8_STAGE(PG8_SA(1, 1), a1 + hstep, voffA);
            PG8_WAIT_L(8); PG8_BAR; PG8_WAIT_L(0); PG8_MMA(0, 0, At, B0); PG8_BAR; PG8_SCHED;
            PG8_LDB(B1, 0, 1); PG8_STAGE(PG8_SB(0, 0), b2, vB);
            PG8_BAR; PG8_WAIT_L(0); PG8_MMA(0, 1, At, B1); PG8_BAR;
            PG8_LDA(At, 0, 1); PG8_STAGE(PG8_SA(0, 0), a2, voffA);
            PG8_BAR; PG8_WAIT_L(0); PG8_MMA(1, 0, At, B0); PG8_BAR; PG8_SCHED;
            PG8_STAGE(PG8_SB(0, 1), b2 + hstep, vB);
            PG8_WAIT_V(6); PG8_BAR; PG8_MMA(1, 1, At, B1); PG8_BAR;
            PG8_LDB(B0, 1, 0); PG8_SCHED; PG8_LDA(At, 1, 0); PG8_STAGE(PG8_SA(0, 1), a2 + hstep, voffA);
            PG8_WAIT_L(8); PG8_BAR; PG8_WAIT_L(0); PG8_MMA(0, 0, At, B0); PG8_BAR; PG8_SCHED;
            PG8_LDB(B1, 1, 1); PG8_STAGE(PG8_SB(1, 0), b3, vB);
            PG8_BAR; PG8_WAIT_L(0); PG8_MMA(0, 1, At, B1); PG8_BAR;
            PG8_LDA(At, 1, 1); PG8_STAGE(PG8_SA(1, 0), a3, voffA);
            PG8_BAR; PG8_WAIT_L(0); PG8_MMA(1, 0, At, B0); PG8_BAR; PG8_SCHED;
            PG8_STAGE(PG8_SB(1, 1), b3 + hstep, vB);
            PG8_WAIT_V(6); PG8_BAR; PG8_MMA(1, 1, At, B1); PG8_BAR;
            }
        }
        if constexpr (ALIGN_EPI) { if (wr == 0) PG8_BAR; }
        E(acc, cur, wr, wc, fr, fq);
        if (!has_next) break;
#pragma unroll
        for (int a = 0; a < 2; ++a)
#pragma unroll
            for (int b = 0; b < 2; ++b)
#pragma unroll
                for (int m = 0; m < 4; ++m)
#pragma unroll
                    for (int n = 0; n < 2; ++n) acc[a][b][m][n] = (f32x4){0.f, 0.f, 0.f, 0.f};
        cur = nxt; cA = nA; cB = nB; ++ui; vBc[0] = vBn[0]; vBc[1] = vBn[1];
        if constexpr (ALIGN_EPI) { if (wr == 1) PG8_BAR; }
    }
    PG8_WAIT_V(0);
    if constexpr (!ALIGN_EPI) { if (wr == 0) PG8_BAR; }
    PG8_BAR;
#undef PG8_SA
#undef PG8_SB
#undef PG8_STAGE
#undef PG8_LDA
#undef PG8_LDB
#undef PG8_MMA
#undef PG8_WAIT_V
#undef PG8_WAIT_L
#undef PG8_BAR
#undef PG8_SCHED
}
}

using pg8::Unit;
typedef f32x4 AccT[2][2][4][2];

struct EpiProj {
    bf16_t *XA, *GA, *Q, *K, *V, *G, *SA, *SB; const float* COS; const float* SIN;
    __device__ __forceinline__ int bkind(const Unit& u) const { const int grp = u.pn >> 2; return (grp == 2 || grp == 3) ? 1 : 0; }
    __device__ __forceinline__ void operator()(const AccT& acc, const Unit& u, int wr, int wc, int fr, int fq) const {
        const int grp = u.pn >> 2;
        if (u.pm == 36 && !(grp == 0 || grp == 2 || grp == 3 || grp == 4)) return;
        const int row0 = u.pm * 256 + wr * 64 + fr;
        if (grp == 2 || grp == 3) {
            bf16_t* dst = (grp == 2) ? Q : K;
            const int c0 = 16 * wc + 4 * fq;
#pragma unroll
            for (int ai = 0; ai < 2; ++ai)
#pragma unroll
                for (int m = 0; m < 4; ++m) {
                    const int r = row0 + ai * 128 + m * 16;
                    if (r >= M1) continue;
                    int trow, nin;
                    if (r < MP) { trow = (r & 2047) + 16; nin = (r & 127) + 1; }
                    else if (r < M) { trow = 2064 + ((r - MP) & 7); nin = ((r - MP) & 7) + 1; }
                    else { trow = r - M; nin = r - M + 1; }
                    const f32x4 cs = *(const f32x4*)(COS + trow * 64 + c0), sn = *(const f32x4*)(SIN + trow * 64 + c0);
#pragma unroll
                    for (int bj = 0; bj < 2; ++bj) {
                        const int head = (u.pn & 3) * 2 + bj;
                        const float e = (float)nin * lg2gamma(head);
                        const float sc = (grp == 2) ? __builtin_amdgcn_exp2f(e) : 0.08838834764831845f * __builtin_amdgcn_exp2f(-e);
                        const f32x4 x1 = acc[ai][bj][m][0], x2 = acc[ai][bj][m][1];
                        const f32x4 o1 = (x1 * cs - x2 * sn) * sc, o2 = (x2 * cs + x1 * sn) * sc;
                        bf16_t* p = dst + (size_t)r * 1024 + head * 128 + c0;
                        u32x2 w1, w2; w1.x = cvt_pk_bf16(o1[0], o1[1]); w1.y = cvt_pk_bf16(o1[2], o1[3]); w2.x = cvt_pk_bf16(o2[0], o2[1]); w2.y = cvt_pk_bf16(o2[2], o2[3]);
                        *(u32x2*)p = w1; *(u32x2*)(p + 64) = w2;
                    }
                }
            return;
        }
        bf16_t* dst; int pitch, colt;
        if (grp == 0) { dst = XA; pitch = 1024; colt = (u.pn & 3) * 256; }
        else if (grp == 1) { dst = GA; pitch = 1024; colt = (u.pn & 3) * 256; }
        else if (grp == 4) { dst = V; pitch = 1024; colt = (u.pn & 3) * 256; }
        else if (grp == 5) { dst = G; pitch = 1024; colt = (u.pn & 3) * 256; }
        else if (grp < 8) { dst = SA; pitch = 2048; colt = (u.pn - 24) * 256; }
        else { dst = SB; pitch = 2048; colt = (u.pn - 32) * 256; }
        const int act = (grp == 1) ? 1 : (grp == 5) ? 2 : (grp >= 6) ? 3 : 0;
        const int col0 = colt + wc * 32 + 8 * fq;
#pragma unroll
        for (int ai = 0; ai < 2; ++ai)
#pragma unroll
            for (int m = 0; m < 4; ++m) {
                const int r = row0 + ai * 128 + m * 16;
                bf16_t* rowp = dst + (size_t)r * pitch + col0;
#pragma unroll
                for (int bj = 0; bj < 2; ++bj) {
                    f32x4 v0 = acc[ai][bj][m][0], v1 = acc[ai][bj][m][1];
                    if (act == 1) {
#pragma unroll
                        for (int j = 0; j < 4; ++j) { v0[j] = gelu_tanh(v0[j]); v1[j] = gelu_tanh(v1[j]); } }
                    else if (act == 2) {
#pragma unroll
                        for (int j = 0; j < 4; ++j) { v0[j] = silu_f(v0[j]); v1[j] = silu_f(v1[j]); } }
                    else if (act == 3) {
#pragma unroll
                        for (int j = 0; j < 4; ++j) { v0[j] = fast_sigmoid(v0[j]); v1[j] = fast_sigmoid(v1[j]); } }
                    u32x4 w; w.x = cvt_pk_bf16(v0[0], v0[1]); w.y = cvt_pk_bf16(v0[2], v0[3]); w.z = cvt_pk_bf16(v1[0], v1[1]); w.w = cvt_pk_bf16(v1[2], v1[3]);
                    *(u32x4*)(rowp + bj * 128) = w;
                }
            }
    }
};

struct EpiMergeA {
    const bf16_t* SA; float* T;
    __device__ __forceinline__ int bkind(const Unit&) const { return 2; }
    __device__ __forceinline__ void operator()(const AccT& acc, const Unit& u, int wr, int wc, int fr, int fq) const {
        const int row0 = u.pm * 256 + wr * 64 + fr, col0 = u.pn * 256 + wc * 32 + 4 * fq;
#pragma unroll
        for (int ai = 0; ai < 2; ++ai)
#pragma unroll
            for (int m = 0; m < 4; ++m) { const size_t off = (size_t)(row0 + ai * 128 + m * 16) * DM + col0;
#pragma unroll
                for (int bj = 0; bj < 2; ++bj)
#pragma unroll
                    for (int n = 0; n < 2; ++n) { const u32x2 s = *(const u32x2*)(SA + off + bj * 128 + n * 16);
                        f32x4 g; g[0] = bf2f(s.x & 0xffffu); g[1] = bf2f(s.x >> 16); g[2] = bf2f(s.y & 0xffffu); g[3] = bf2f(s.y >> 16);
                        *(f32x4*)(T + off + bj * 128 + n * 16) = acc[ai][bj][m][n] * g; } }
    }
};
struct EpiMergeB {
    const bf16_t* SB; const float* T; bf16_t* MG;
    __device__ __forceinline__ int bkind(const Unit&) const { return 2; }
    __device__ __forceinline__ void operator()(const AccT& acc, const Unit& u, int wr, int wc, int fr, int fq) const {
        const int row0 = u.pm * 256 + wr * 64 + fr, col0 = u.pn * 256 + wc * 32 + 4 * fq;
#pragma unroll
        for (int ai = 0; ai < 2; ++ai)
#pragma unroll
            for (int m = 0; m < 4; ++m) { const size_t off = (size_t)(row0 + ai * 128 + m * 16) * DM + col0;
#pragma unroll
                for (int bj = 0; bj < 2; ++bj)
#pragma unroll
                    for (int n = 0; n < 2; ++n) { const u32x2 s = *(const u32x2*)(SB + off + bj * 128 + n * 16);
                        f32x4 g; g[0] = bf2f(s.x & 0xffffu); g[1] = bf2f(s.x >> 16); g[2] = bf2f(s.y & 0xffffu); g[3] = bf2f(s.y >> 16);
                        const f32x4 t = *(const f32x4*)(T + off + bj * 128 + n * 16);
                        const f32x4 o = t + acc[ai][bj][m][n] * g;
                        u32x2 w; w.x = cvt_pk_bf16(o[0], o[1]); w.y = cvt_pk_bf16(o[2], o[3]);
                        *(u32x2*)(MG + off + bj * 128 + n * 16) = w; } }
    }
};
struct EpiRes1 {
    const float* xp; const float* xs; float* X1; bf16_t* X1N; const float* gf; float* ss;
    __device__ __forceinline__ int bkind(const Unit&) const { return 2; }
    __device__ __forceinline__ void operator()(const AccT& acc, const Unit& u, int wr, int wc, int fr, int fq) const {
        const int row0 = u.pm * 256 + wr * 64 + fr, col0 = u.pn * 256 + wc * 32 + 4 * fq;
        const float* xin = (u.pm < 32) ? xp : (xs - (size_t)MP * DM);
        f32x4 gv[2][2];
#pragma unroll
        for (int bj = 0; bj < 2; ++bj)
#pragma unroll
            for (int n = 0; n < 2; ++n) gv[bj][n] = *(const f32x4*)(gf + col0 + bj * 128 + n * 16);
#pragma unroll
        for (int ai = 0; ai < 2; ++ai)
#pragma unroll
            for (int m = 0; m < 4; ++m) { const int r = row0 + ai * 128 + m * 16; const size_t off = (size_t)r * DM + col0; float s = 0.f;
#pragma unroll
                for (int bj = 0; bj < 2; ++bj)
#pragma unroll
                    for (int n = 0; n < 2; ++n) { const f32x4 x = *(const f32x4*)(xin + off + bj * 128 + n * 16); const f32x4 o = x + acc[ai][bj][m][n];
                        *(f32x4*)(X1 + off + bj * 128 + n * 16) = o; s += (o[0] * o[0] + o[1] * o[1]) + (o[2] * o[2] + o[3] * o[3]);
                        const f32x4 h = o * gv[bj][n]; u32x2 w; w.x = cvt_pk_bf16(h[0], h[1]); w.y = cvt_pk_bf16(h[2], h[3]);
                        *(u32x2*)(X1N + off + bj * 128 + n * 16) = w; }
                s += __shfl_xor(s, 16); s += __shfl_xor(s, 32);
                if (fq == 0) atomicAdd(ss + r, s); }
    }
};
struct EpiUp {
    const float* ss; bf16_t* U;
    __device__ __forceinline__ int bkind(const Unit&) const { return 0; }
    __device__ __forceinline__ void operator()(const AccT& acc, const Unit& u, int wr, int wc, int fr, int fq) const {
        const int row0 = u.pm * 256 + wr * 64 + fr, col0 = u.pn * 256 + wc * 32 + 8 * fq;
#pragma unroll
        for (int ai = 0; ai < 2; ++ai)
#pragma unroll
            for (int m = 0; m < 4; ++m) { const int r = row0 + ai * 128 + m * 16;
                const float rstd = __builtin_amdgcn_rsqf(__hip_atomic_load(ss + r, __ATOMIC_RELAXED, __HIP_MEMORY_SCOPE_AGENT) * (1.0f / DM) + EPS);
                bf16_t* rowp = U + (size_t)r * DFF + col0;
#pragma unroll
                for (int bj = 0; bj < 2; ++bj) { f32x4 v0 = acc[ai][bj][m][0] * rstd, v1 = acc[ai][bj][m][1] * rstd;
#pragma unroll
                    for (int j = 0; j < 4; ++j) { const float a = fmaxf(v0[j], 0.f), b = fmaxf(v1[j], 0.f); v0[j] = a * a; v1[j] = b * b; }
                    u32x4 w; w.x = cvt_pk_bf16(v0[0], v0[1]); w.y = cvt_pk_bf16(v0[2], v0[3]); w.z = cvt_pk_bf16(v1[0], v1[1]); w.w = cvt_pk_bf16(v1[2], v1[3]);
                    *(u32x4*)(rowp + bj * 128) = w; } }
    }
};
struct EpiDown {
    float* X; float* ss;
    __device__ __forceinline__ int bkind(const Unit&) const { return 2; }
    __device__ __forceinline__ void operator()(const AccT& acc, const Unit& u, int wr, int wc, int fr, int fq) const {
        const int row0 = u.pm * 256 + wr * 64 + fr, col0 = u.pn * 256 + wc * 32 + 4 * fq;
#pragma unroll
        for (int ai = 0; ai < 2; ++ai)
#pragma unroll
            for (int m = 0; m < 4; ++m) { const int r = row0 + ai * 128 + m * 16; const size_t off = (size_t)r * DM + col0; float s = 0.f;
#pragma unroll
                for (int bj = 0; bj < 2; ++bj)
#pragma unroll
                    for (int n = 0; n < 2; ++n) { const f32x4 x = *(const f32x4*)(X + off + bj * 128 + n * 16); const f32x4 o = x + acc[ai][bj][m][n];
                        *(f32x4*)(X + off + bj * 128 + n * 16) = o; s += (o[0] * o[0] + o[1] * o[1]) + (o[2] * o[2] + o[3] * o[3]); }
                s += __shfl_xor(s, 16); s += __shfl_xor(s, 32);
                if (fq == 0) atomicAdd(ss + r, s); }
    }
};

#define XB_TMO      128
#define XB_XCNT(j)  (256  + 64 * (j))
#define XB_XSUB(j)  (1280 + 64 * (j))
#define XB_XGEN(j)  (2304 + 64 * (j))
#define XB_TOP      3328
#define XB_TOPGEN   3392
#define XCD_BAR_WORDS 3456
#define XB_SPIN_CAP (1u << 18)
__device__ __forceinline__ unsigned xb_ld(unsigned* p)              { return __hip_atomic_load(p, __ATOMIC_RELAXED, __HIP_MEMORY_SCOPE_AGENT); }
__device__ __forceinline__ unsigned xb_add(unsigned* p, unsigned v) { return __hip_atomic_fetch_add(p, v, __ATOMIC_RELAXED, __HIP_MEMORY_SCOPE_AGENT); }
__device__ __forceinline__ unsigned xb_xcc_id() { return (unsigned)__builtin_amdgcn_s_getreg((3 << 11) | 20) & 0xFu; }
#define XB_SPIN(cond, bar) do { unsigned _sp = 0; while (cond) { __builtin_amdgcn_s_sleep(1); \
    if ((++_sp & 255u) == 0u) { if (xb_ld(&(bar)[XB_TMO])) break; if (_sp > XB_SPIN_CAP) { atomicAdd(&(bar)[XB_TMO], 1u); break; } } } } while (0)
struct XcdBarrier { unsigned* bar; unsigned x; volatile LAS unsigned* st; };
__device__ __forceinline__ XcdBarrier xcd_barrier_post(unsigned* bar, volatile LAS unsigned* st) {
    XcdBarrier b; b.bar = bar; b.x = xb_xcc_id(); b.st = st;
    if (threadIdx.x == 0) (void)xb_add(&bar[XB_XCNT(b.x)], 1u);
    return b;
}
__device__ __forceinline__ void xcd_barrier_complete(unsigned* bar, unsigned x, unsigned& nloc, unsigned& nx) {
    const unsigned G = gridDim.x * gridDim.y * gridDim.z;
    unsigned sum, cnt, mine, sp = 0u;
    for (;;) {
        sum = 0u; cnt = 0u; mine = 0u;
#pragma unroll
        for (unsigned j = 0; j < 16; ++j) { const unsigned c = xb_ld(&bar[XB_XCNT(j)]); sum += c; cnt += (c > 0u) ? 1u : 0u; mine = (j == x) ? c : mine; }
        if (sum == G) break;
        __builtin_amdgcn_s_sleep(1);
        if ((++sp & 255u) == 0u) { if (xb_ld(&bar[XB_TMO])) break; if (sp > XB_SPIN_CAP) { atomicAdd(&bar[XB_TMO], 1u); break; } }
    }
    nloc = mine > 0u ? mine : 1u; nx = cnt > 0u ? cnt : 1u;
}
__device__ __forceinline__ void xcd_barrier(const XcdBarrier& b) {
    asm volatile("s_waitcnt vmcnt(0)" ::: "memory");
    __syncthreads();
    if (threadIdx.x == 0) {
        unsigned* bar = b.bar;
        __builtin_amdgcn_s_waitcnt(0);
        unsigned nloc = b.st[0], nx = b.st[1];
        if (nloc == 0u) { xcd_barrier_complete(bar, b.x, nloc, nx); b.st[0] = nloc; b.st[1] = nx; }
        const unsigned old = xb_add(&bar[XB_XSUB(b.x)], 1u);
        const unsigned gen = old / nloc;
        if (old + 1u == (gen + 1u) * nloc) {
            __builtin_amdgcn_fence(__ATOMIC_RELEASE, "agent");
            asm volatile("s_waitcnt vmcnt(0)" ::: "memory");
            const unsigned og = xb_add(&bar[XB_TOP], 1u);
            const unsigned tg = og / nx;
            if (og + 1u == (tg + 1u) * nx) xb_add(&bar[XB_TOPGEN], 1u);
            else XB_SPIN(xb_ld(&bar[XB_TOPGEN]) == tg, bar);
            __builtin_amdgcn_fence(__ATOMIC_ACQUIRE, "agent");
            xb_add(&bar[XB_XGEN(b.x)], 1u);
            asm volatile("s_waitcnt vmcnt(0)" ::: "memory");
        } else {
            XB_SPIN(xb_ld(&bar[XB_XGEN(b.x)]) == gen, bar);
            __builtin_amdgcn_fence(__ATOMIC_ACQUIRE, "agent");
            asm volatile("s_waitcnt vmcnt(0)" ::: "memory");
        }
    }
    __syncthreads();
}

constexpr int RING_BYTES = 131072;
constexpr int LDSCTL_OFF = RING_BYTES, MISC_OFF = LDSCTL_OFF + 320;
constexpr int LDS_BYTES = 147456;
constexpr int NWAVES = 8, NTHR = 512;

struct Params { const float* in[23]; float* out; unsigned char* ws; int ph_lo, ph_hi, li, pad; };
struct Ctx { LAS unsigned char* lds; int tid, lane, wave, vcu, G; };

__device__ __forceinline__ void p0_transpose_item(const float* W, int K, int N, bf16_t* WT, LAS float* scr, int item, int lane) {
    const int nblk = N / 32, kb = item / nblk, nb = item % nblk, k0 = 64 * kb, n0 = 32 * nb;
#pragma unroll 8
    for (int i = 0; i < 32; ++i) { const int kk = 2 * i + (lane >> 5); scr[kk * 33 + (lane & 31)] = W[(size_t)(k0 + kk) * N + n0 + (lane & 31)]; }
    LDS_WAIT(); asm volatile("" ::: "memory");
    const int c = lane & 7;
#pragma unroll
    for (int j = 0; j < 4; ++j) { const int n = (lane >> 3) + 8 * j; const LAS float* s = scr + (8 * c) * 33 + n;
        u32x4 o; o.x = pk2(s[0 * 33], s[1 * 33]); o.y = pk2(s[2 * 33], s[3 * 33]); o.z = pk2(s[4 * 33], s[5 * 33]); o.w = pk2(s[6 * 33], s[7 * 33]);
        *(u32x4*)(WT + (size_t)(n0 + n) * K + k0 + 8 * c) = o; }
    LDS_WAIT(); asm volatile("" ::: "memory");
}
__device__ __forceinline__ void rms_row_to_bf16(const float* xrow, const float* g, bf16_t* orow, int lane) {
    const f32x4* xr = (const f32x4*)xrow + lane; const f32x4* gr = (const f32x4*)g + lane;
    f32x4 v[8]; float s = 0.f;
#pragma unroll
    for (int j = 0; j < 8; ++j) { v[j] = xr[64 * j]; s += (v[j][0] * v[j][0] + v[j][1] * v[j][1]) + (v[j][2] * v[j][2] + v[j][3] * v[j][3]); }
    const float rstd = 1.0f / sqrtf(wave_sum(s) * (1.f / DM) + EPS);
    u32x2* o8 = (u32x2*)orow + lane;
#pragma unroll
    for (int j = 0; j < 8; ++j) { const f32x4 gg = gr[64 * j]; u32x2 w; w.x = pk2(v[j][0] * rstd * gg[0], v[j][1] * rstd * gg[1]); w.y = pk2(v[j][2] * rstd * gg[2], v[j][3] * rstd * gg[3]); o8[64 * j] = w; }
}
__device__ __forceinline__ void sincos_entry(int idx, float* COS, float* SIN) {
    const int tr = idx >> 6, i = idx & 63;
    const double pos = (tr < 2064) ? (double)tr : (double)(16384 + (tr - 2064));
    const double ang = pos * INVF[i];
    const double k = __builtin_rint(ang * 0.63661977236758134308);
    double y = __builtin_fma(-k, 1.57079632679489655800e+00, ang);
    y = __builtin_fma(-k, 6.12323399573676603587e-17, y);
    const double z = y * y;
    double sp = -7.6471637318198164759e-13;
    sp = sp * z + 1.6059043836821614599e-10;
    sp = sp * z - 2.5052108385441718775e-08;
    sp = sp * z + 2.7557319223985890653e-06;
    sp = sp * z - 1.9841269841269841270e-04;
    sp = sp * z + 8.3333333333333333333e-03;
    sp = sp * z - 1.6666666666666666667e-01;
    const double s = y + y * z * sp;
    double cp = 4.7794773323873852974e-14;
    cp = cp * z - 1.1470745597729724714e-11;
    cp = cp * z + 2.0876756987868098979e-09;
    cp = cp * z - 2.7557319223985890653e-07;
    cp = cp * z + 2.4801587301587301587e-05;
    cp = cp * z - 1.3888888888888888889e-03;
    cp = cp * z + 4.1666666666666666667e-02;
    cp = cp * z - 0.5;
    const double c = 1.0 + z * cp;
    const int q = ((int)(long long)k) & 3;
    const double sv = (q == 0) ? s : (q == 1) ? c : (q == 2) ? -s : -c;
    const double cv = (q == 0) ? c : (q == 1) ? -s : (q == 2) ? -c : s;
    COS[idx] = (float)cv; SIN[idx] = (float)sv;
}
__device__ __forceinline__ void p0_prep(const Ctx& C, const Params& P) {
    unsigned char* ws = P.ws;
    LAS float* scr = (LAS float*)(C.lds + C.wave * 16384);
    const int gw = C.vcu * NWAVES + C.wave, NGW = C.G * NWAVES;
    constexpr int I_IN = (DM / 64) * (DPROJ / 32), I_UP = (DM / 64) * (DFF / 32), I_DN = (DFF / 64) * (DM / 32), I_OUT = (DM / 64) * (DM / 32), I_PA = (LW / 64) * (DM / 32);
    constexpr int NITEMS = I_IN + I_UP + I_DN + I_OUT + 2 * I_PA;
    for (int it = gw; it < NITEMS; it += NGW) {
        int r = it;
        if (r < I_IN) { p0_transpose_item(P.in[7], DM, DPROJ, (bf16_t*)(ws + WS_WIN), scr, r, C.lane); continue; } r -= I_IN;
        if (r < I_UP) { p0_transpose_item(P.in[20], DM, DFF, (bf16_t*)(ws + WS_WUP), scr, r, C.lane); continue; } r -= I_UP;
        if (r < I_DN) { p0_transpose_item(P.in[21], DFF, DM, (bf16_t*)(ws + WS_WDN), scr, r, C.lane); continue; } r -= I_DN;
        if (r < I_OUT) { p0_transpose_item(P.in[18], DM, DM, (bf16_t*)(ws + WS_WOUT), scr, r, C.lane); continue; } r -= I_OUT;
        if (r < I_PA) { p0_transpose_item(P.in[16], LW, DM, (bf16_t*)(ws + WS_PA), scr, r, C.lane); continue; } r -= I_PA;
        p0_transpose_item(P.in[17], LW, DM, (bf16_t*)(ws + WS_PB), scr, r, C.lane);
    }
    bf16_t* H = (bf16_t*)(ws + WS_H);
    for (int m = gw; m < M1PAD; m += NGW) {
        bf16_t* orow = H + (size_t)m * DM;
        if (m < M1) {
            const float* xrow = (m < MP) ? P.in[0] + (size_t)m * DM : (m < M) ? P.in[1] + (size_t)(m - MP) * DM : P.in[5] + (size_t)(m - M) * DM;
            rms_row_to_bf16(xrow, P.in[6], orow, C.lane);
        } else {
            u32x2* o8 = (u32x2*)orow + C.lane;
#pragma unroll
            for (int j = 0; j < 8; ++j) o8[64 * j] = (u32x2){0u, 0u};
        }
    }
    float* COS = (float*)(ws + WS_TAB); float* SIN = COS + TABROWS * 64;
    const int gt = C.vcu * NTHR + C.tid, NGT = C.G * NTHR;
    for (int i = gt; i < TABROWS * 64; i += NGT) sincos_entry(i, COS, SIN);
    float* ss = (float*)(ws + WS_SS);
    for (int i = gt; i < 2 * M; i += NGT) ss[i] = 0.f;
    bf16_t* waT = (bf16_t*)(ws + WS_LRUW); bf16_t* wxT = waT + NBLK * 4096;
    for (int i = gt; i < 2 * NBLK * 4096; i += NGT) {
        const int g = i >> 16, r = i & 65535, n = r >> 12, d = (r >> 6) & 63, c = r & 63;
        const float* src = g ? P.in[12] : P.in[10];
        (g ? wxT : waT)[r] = (bf16_t)f2bf(src[(n * 64 + c) * 64 + d]);
    }
}

__device__ __forceinline__ void p2_gates_simple(const Ctx& C, const Params& P, float* Aarr, float* Barr) {
    unsigned char* ws = P.ws;
    const bf16_t* XA = (const bf16_t*)(ws + WS_XA);
    float* metaA = (float*)(ws + WS_METAAB); float* metaB = metaA + NMETA * LW;
    const float* state_conv = P.in[2]; const float* conv_w = P.in[8]; const float* conv_b = P.in[9];
    const float* wa = P.in[10]; const float* ba = P.in[11]; const float* wx = P.in[12]; const float* bx = P.in[13]; const float* lam = P.in[14];
    LAS float* xcs = (LAS float*)C.lds;
    const int rl = C.tid >> 6, d = C.tid & 63;
    constexpr int NRG = M1 / 8;
    for (int item = C.vcu; item < NRG * NBLK; item += C.G) {
        const int n = item / NRG, rg = item % NRG;
        const int row = rg * 8 + rl, ch = n * 64 + d;
        float xc = conv_b[ch];
#pragma unroll
        for (int j = 0; j < 4; ++j) {
            float val;
            if (row < MP) { const int b = row >> 11, t = row & 2047, tt = t - 3 + j; val = bf2f(XA[(size_t)(tt >= 0 ? (b * 2048 + tt) : (MROW_META + 16 + tt)) * LW + ch]); }
            else if (row < M) { const int s = row - MP, b = s >> 3, t = s & 7, tt = t - 3 + j; val = (tt >= 0) ? bf2f(XA[(size_t)(MP + b * 8 + tt) * LW + ch]) : state_conv[((size_t)b * 3 + (3 + tt)) * LW + ch]; }
            else { const int t = row - M, tt = t - 3 + j; val = (tt >= 0) ? bf2f(XA[(size_t)(MROW_META + tt) * LW + ch]) : 0.f; }
            xc += conv_w[j * LW + ch] * val;
        }
        xcs[rl * 64 + d] = xc;
        __syncthreads();
        float rp = ba[ch], ip = bx[ch];
        const float* wan = wa + (size_t)n * 4096 + d; const float* wxn = wx + (size_t)n * 4096 + d;
#pragma unroll 8
        for (int c = 0; c < 64; ++c) { const float x = xcs[rl * 64 + c]; rp += x * wan[c * 64]; ip += x * wxn[c * 64]; }
        const float r = 1.0f / (1.0f + __expf(-rp)), ig = 1.0f / (1.0f + __expf(-ip));
        const float e = __expf(-lam[ch]);
        const float L = -8.0f * (e * (1.0f - e * (0.5f - e * (0.33333333f - 0.25f * e))));
        const float a = __expf(r * L);
        float mult = sqrtf(fmaxf(1.0f - a * a, 0.f));
        if (row == MROW_META) mult = 1.0f;
        const float bt = mult * ig * xc;
        if (row < M) { Aarr[(size_t)row * LW + ch] = a; Barr[(size_t)row * LW + ch] = bt; }
        else { metaA[(row - M) * LW + ch] = a; metaB[(row - M) * LW + ch] = bt; }
        __syncthreads();
    }
}
__device__ __forceinline__ void p2_scan_simple(const Ctx& C, const Params& P, const float* Aarr, const float* Barr) {
    unsigned char* ws = P.ws;
    const bf16_t* XA = (const bf16_t*)(ws + WS_XA); const bf16_t* GA = (const bf16_t*)(ws + WS_GA); bf16_t* YA = (bf16_t*)(ws + WS_YA);
    const float* metaA = (const float*)(ws + WS_METAAB); const float* metaB = metaA + NMETA * LW;
    float* out = P.out;
    const int gt = C.vcu * NTHR + C.tid, NGT = C.G * NTHR;
    for (int i = gt; i < (NB + DECB) * LW; i += NGT) {
        const int s = i >> 10, ch = i & 1023;
        if (s < NB) {
            float h = 0.f;
            for (int t = 0; t < NMETA; ++t) h = metaA[t * LW + ch] * h + metaB[t * LW + ch];
            const size_t base = (size_t)s * SEQ * LW + ch;
#pragma unroll 8
            for (int t = 0; t < SEQ; ++t) { const size_t o = base + (size_t)t * LW; h = Aarr[o] * h + Barr[o]; YA[o] = (bf16_t)f2bf(h * bf2f(GA[o])); }
            out[O_NLP + s * LW + ch] = h;
#pragma unroll
            for (int j = 0; j < 3; ++j) out[O_NCP + ((size_t)s * 3 + j) * LW + ch] = bf2f(XA[base + (size_t)(SEQ - 3 + j) * LW]);
        } else {
            const int b = s - NB;
            float h = P.in[3][b * LW + ch];
            const size_t base = (size_t)(MP + b * 8) * LW + ch;
#pragma unroll
            for (int t = 0; t < DECS; ++t) { const size_t o = base + (size_t)t * LW; h = Aarr[o] * h + Barr[o]; YA[o] = (bf16_t)f2bf(h * bf2f(GA[o])); }
            out[O_NLS + b * LW + ch] = h;
#pragma unroll
            for (int j = 0; j < 3; ++j) out[O_NCS + ((size_t)b * 3 + j) * LW + ch] = bf2f(XA[base + (size_t)(DECS - 3 + j) * LW]);
        }
    }
}
__device__ __forceinline__ void p2_ret_simple(const Ctx& C, const Params& P) {
    unsigned char* ws = P.ws;
    const bf16_t* Q = (const bf16_t*)(ws + WS_Q); const bf16_t* K = (const bf16_t*)(ws + WS_K); const bf16_t* V = (const bf16_t*)(ws + WS_V); const bf16_t* G = (const bf16_t*)(ws + WS_G);
    bf16_t* YB = (bf16_t*)(ws + WS_YB);
    const float* gn = P.in[15]; const float* S0 = P.in[4]; float* out = P.out;
    LAS float* qs = (LAS float*)C.lds;
    LAS float* ks = qs + 2048; LAS float* vs = ks + 2048;
    LAS float* red = vs + 2048;
    LAS float* st = red + 8192;
    const int v = C.tid & 127, dq = C.tid >> 7;
    for (int item = C.vcu; item < (NB + DECB) * RH; item += C.G) {
        const int s = item >> 3, h = item & 7;
        const bool prompt = s < NB;
        const float lg = lg2gamma(h);
        float Z[32];
        if (prompt) {
#pragma unroll
            for (int j = 0; j < 32; ++j) Z[j] = 0.f;
        } else {
            const float* sp = S0 + (((size_t)(s - NB) * RH + h) * DK + dq * 32) * 128 + v;
#pragma unroll
            for (int j = 0; j < 32; ++j) Z[j] = sp[(size_t)j * 128];
        }
        const int nbatch = prompt ? 129 : 1;
        for (int bi = 0; bi < nbatch; ++bi) {
            const int ntok = prompt ? 16 : 8;
            const int rowb = prompt ? (bi == 0 ? MROW_META : s * SEQ + (bi - 1) * 16) : MP + (s - NB) * 8;
            __syncthreads();
            for (int idx = C.tid; idx < 3 * ntok * 128; idx += NTHR) {
                const int arr = idx / (ntok * 128), rem = idx % (ntok * 128), tok = rem >> 7, e = rem & 127;
                const bf16_t* src = (arr == 0) ? Q : (arr == 1) ? K : V;
                const float val = bf2f(src[(size_t)(rowb + tok) * 1024 + h * 128 + e]);
                ((arr == 0) ? qs : (arr == 1) ? ks : vs)[tok * 128 + e] = val;
            }
            __syncthreads();
            for (int tok = 0; tok < ntok; ++tok) {
                const float vv = vs[tok * 128 + v]; float part = 0.f;
#pragma unroll
                for (int j = 0; j < 32; ++j) { Z[j] = fmaf(ks[tok * 128 + dq * 32 + j], vv, Z[j]); part = fmaf(qs[tok * 128 + dq * 32 + j], Z[j], part); }
                red[(tok * 4 + dq) * 128 + v] = part;
            }
            __syncthreads();
            const int per = ntok >> 2;
            float o[4];
#pragma unroll
            for (int i = 0; i < 4; ++i) { o[i] = 0.f; if (i < per) { const int tok = dq * per + i; o[i] = (red[(tok * 4 + 0) * 128 + v] + red[(tok * 4 + 1) * 128 + v]) + (red[(tok * 4 + 2) * 128 + v] + red[(tok * 4 + 3) * 128 + v]);
                    const float s1 = wave_sum(o[i]), s2 = wave_sum(o[i] * o[i]);
                    if (C.lane == 0) { st[(tok * 2 + (C.wave & 1)) * 2 + 0] = s1; st[(tok * 2 + (C.wave & 1)) * 2 + 1] = s2; } } }
            __syncthreads();
            const bool want_y = !(prompt && bi == 0);
#pragma unroll
            for (int i = 0; i < 4; ++i) if (i < per && want_y) { const int tok = dq * per + i;
                    const float mu = (st[(tok * 2 + 0) * 2 + 0] + st[(tok * 2 + 1) * 2 + 0]) * (1.f / 128.f);
                    const float var = (st[(tok * 2 + 0) * 2 + 1] + st[(tok * 2 + 1) * 2 + 1]) * (1.f / 128.f) - mu * mu;
                    const float y = (o[i] - mu) * (1.0f / sqrtf(fmaxf(var, 0.f) + EPS)) * gn[h * 128 + v];
                    const size_t off = (size_t)(rowb + tok) * 1024 + h * 128 + v;
                    YB[off] = (bf16_t)f2bf(y * bf2f(G[off])); }
            float sc = 1.f;
            if (!prompt) sc = __builtin_amdgcn_exp2f(8.f * lg);
            else if (bi == 0) sc = __builtin_amdgcn_exp2f(16.f * lg);
            else if ((bi & 7) == 0) sc = __builtin_amdgcn_exp2f(128.f * lg);
            if (sc != 1.f) {
#pragma unroll
                for (int j = 0; j < 32; ++j) Z[j] *= sc; }
        }
        float* dst = prompt ? out + O_NRP + (((size_t)s * RH + h) * DK + dq * 32) * 128 + v : out + O_NRS + (((size_t)(s - NB) * RH + h) * DK + dq * 32) * 128 + v;
#pragma unroll
        for (int j = 0; j < 32; ++j) dst[(size_t)j * 128] = Z[j];
    }
}

typedef short v4i16_t __attribute__((ext_vector_type(4)));
constexpr int XCB_STRIDE = 144;
constexpr int XCF_STRIDE = 68;
constexpr int LRU_XCB = 0, LRU_XCF = 128 * XCB_STRIDE, LRU_WT = LRU_XCF + 128 * XCF_STRIDE * 4, LRU_HIN = LRU_WT + 8 * 64 * 2 * 4, LRU_END = LRU_HIN + 256;
template <int MODE, bool FINAL>
__device__ __forceinline__ void lru_tile(const Ctx& C, const Params& P, const int n, const int idx) {
    unsigned char* ws = P.ws;
    const bf16_t* XA = (const bf16_t*)(ws + WS_XA); const bf16_t* GA = (const bf16_t*)(ws + WS_GA); bf16_t* YA = (bf16_t*)(ws + WS_YA);
    const bf16_t* waT = (const bf16_t*)(ws + WS_LRUW) + n * 4096; const bf16_t* wxT = waT + NBLK * 4096;
    float* SUMM = (float*)(ws + WS_SUMM); float* SUMMETA = (float*)(ws + WS_SUMMETA);
    LAS unsigned char* lds = C.lds;
    LAS float* XCF = (LAS float*)(lds + LRU_XCF); LAS float* WT = (LAS float*)(lds + LRU_WT); LAS float* HIN = (LAS float*)(lds + LRU_HIN);
    const int tid = C.tid, lane = C.lane, w = C.wave, fr = lane & 15, fq = lane >> 4;
    const int b = idx >> 4, c = idx & 15;
    const int r0 = (MODE == 0) ? b * SEQ + c * 128 : (MODE == 1) ? MP + idx * 128 : MROW_META;
    const int t = tid >> 2, cg = tid & 3, ch0 = n * 64 + cg * 16;
    float xc[16];
    {
        const f32x4* cb = (const f32x4*)(P.in[9] + ch0);
#pragma unroll
        for (int q = 0; q < 4; ++q) { const f32x4 v = cb[q]; xc[4 * q] = v[0]; xc[4 * q + 1] = v[1]; xc[4 * q + 2] = v[2]; xc[4 * q + 3] = v[3]; }
    }
    u32x4 raw3[2];
#pragma unroll
    for (int j = 0; j < 4; ++j) {
        const int tt = t - 3 + j;
        float xv[16];
        bool from_state = false; int srow = r0 + tt; bool zero = false;
        if (MODE == 0) { if (c == 0 && tt < 0) srow = M1 + tt; }
        else if (MODE == 1) { const int ts = (t & 7) - 3 + j; if (ts < 0) from_state = true; }
        else { if (tt < 0) zero = true; }
        if (MODE == 1 && from_state) {
            const int bseq = idx * 16 + (t >> 3), ts = (t & 7) - 3 + j;
            const f32x4* sp = (const f32x4*)(P.in[2] + ((size_t)bseq * 3 + (3 + ts)) * LW + ch0);
#pragma unroll
            for (int q = 0; q < 4; ++q) { const f32x4 v = sp[q]; xv[4 * q] = v[0]; xv[4 * q + 1] = v[1]; xv[4 * q + 2] = v[2]; xv[4 * q + 3] = v[3]; }
        } else {
            const u32x4* xp = (const u32x4*)(XA + (size_t)(zero ? r0 : srow) * LW + ch0);
            u32x4 v0 = xp[0], v1 = xp[1];
            if (zero) { v0 = (u32x4){0u, 0u, 0u, 0u}; v1 = v0; }
            if (j == 3) { raw3[0] = v0; raw3[1] = v1; }
#pragma unroll
            for (int q = 0; q < 4; ++q) { xv[2 * q] = bf2f(v0[q] & 0xffffu); xv[2 * q + 1] = bf2f(v0[q] >> 16); xv[8 + 2 * q] = bf2f(v1[q] & 0xffffu); xv[8 + 2 * q + 1] = bf2f(v1[q] >> 16); }
        }
        const f32x4* cw = (const f32x4*)(P.in[8] + j * LW + ch0);
#pragma unroll
        for (int q = 0; q < 4; ++q) { const f32x4 wv = cw[q]; xc[4 * q] += wv[0] * xv[4 * q]; xc[4 * q + 1] += wv[1] * xv[4 * q + 1]; xc[4 * q + 2] += wv[2] * xv[4 * q + 2]; xc[4 * q + 3] += wv[3] * xv[4 * q + 3]; }
    }
    u32x4 gav[2];
    if (FINAL) { const u32x4* gp = (const u32x4*)(GA + (size_t)(r0 + t) * LW + ch0); gav[0] = gp[0]; gav[1] = gp[1]; }
    if (FINAL && MODE == 0 && c == 15 && t >= 125) {
        float* dst = P.out + O_NCP + ((size_t)b * 3 + (t - 125)) * LW + ch0;
#pragma unroll
        for (int q = 0; q < 4; ++q) { *(f32x4*)(dst + 4 * q) = (f32x4){bf2f(raw3[q >> 1][(2 * q) & 3] & 0xffffu), bf2f(raw3[q >> 1][(2 * q) & 3] >> 16), bf2f(raw3[q >> 1][(2 * q + 1) & 3] & 0xffffu), bf2f(raw3[q >> 1][(2 * q + 1) & 3] >> 16)}; }
    }
    if (FINAL && MODE == 1 && (t & 7) >= 5) {
        float* dst = P.out + O_NCS + ((size_t)(idx * 16 + (t >> 3)) * 3 + ((t & 7) - 5)) * LW + ch0;
#pragma unroll
        for (int q = 0; q < 4; ++q) { *(f32x4*)(dst + 4 * q) = (f32x4){bf2f(raw3[q >> 1][(2 * q) & 3] & 0xffffu), bf2f(raw3[q >> 1][(2 * q) & 3] >> 16), bf2f(raw3[q >> 1][(2 * q + 1) & 3] & 0xffffu), bf2f(raw3[q >> 1][(2 * q + 1) & 3] >> 16)}; }
    }
    __syncthreads();
    {
        u32x4 p0, p1;
        p0.x = pk2(xc[0], xc[1]); p0.y = pk2(xc[2], xc[3]); p0.z = pk2(xc[4], xc[5]); p0.w = pk2(xc[6], xc[7]);
        p1.x = pk2(xc[8], xc[9]); p1.y = pk2(xc[10], xc[11]); p1.z = pk2(xc[12], xc[13]); p1.w = pk2(xc[14], xc[15]);
        LAS u32x4* d = (LAS u32x4*)(lds + LRU_XCB + t * XCB_STRIDE + cg * 32); d[0] = p0; d[1] = p1;
        LAS f32x4* f = (LAS f32x4*)(XCF + t * XCF_STRIDE + cg * 16);
#pragma unroll
        for (int q = 0; q < 4; ++q) f[q] = (f32x4){xc[4 * q], xc[4 * q + 1], xc[4 * q + 2], xc[4 * q + 3]};
    }
    if (FINAL && MODE == 0 && tid < 64) {
        const float* sm = SUMM + ((size_t)(b * 16) * 16 + n) * 128 + tid;
        float pj[15], hj[15];
#pragma unroll
        for (int j = 0; j < 15; ++j) { const bool on = j < c; pj[j] = on ? sm[(size_t)j * 2048] : 1.f; hj[j] = on ? sm[(size_t)j * 2048 + 64] : 0.f; }
        float h = SUMMETA[n * 128 + 64 + tid];
#pragma unroll
        for (int j = 0; j < 15; ++j) h = pj[j] * h + hj[j];
        HIN[tid] = h;
    }
    __syncthreads();
    f32x4 Racc[4], Iacc[4];
    {
        bf16x8 af[2];
#pragma unroll
        for (int ks = 0; ks < 2; ++ks) af[ks] = *(const LAS bf16x8*)(lds + LRU_XCB + (16 * w + fr) * XCB_STRIDE + (ks * 32 + fq * 8) * 2);
#pragma unroll
        for (int dt = 0; dt < 4; ++dt) {
            Racc[dt] = (f32x4){0.f, 0.f, 0.f, 0.f}; Iacc[dt] = (f32x4){0.f, 0.f, 0.f, 0.f};
#pragma unroll
            for (int ks = 0; ks < 2; ++ks) {
                const bf16x8 bw = *(const bf16x8*)(waT + (16 * dt + fr) * 64 + ks * 32 + fq * 8);
                const bf16x8 bx = *(const bf16x8*)(wxT + (16 * dt + fr) * 64 + ks * 32 + fq * 8);
                Racc[dt] = __builtin_amdgcn_mfma_f32_16x16x32_bf16(af[ks], bw, Racc[dt], 0, 0, 0);
                Iacc[dt] = __builtin_amdgcn_mfma_f32_16x16x32_bf16(af[ks], bx, Iacc[dt], 0, 0, 0);
            }
        }
    }
    float av[4][4], bv[4][4];
#pragma unroll
    for (int dt = 0; dt < 4; ++dt) {
        const int ch = n * 64 + 16 * dt + fr;
        const float ba = P.in[11][ch], bx = P.in[13][ch];
        const float e = __expf(-P.in[14][ch]);
        const float L2 = -8.0f * 1.4426950409f * (e * (1.0f - e * (0.5f - e * (0.33333333f - 0.25f * e))));
#pragma unroll
        for (int r = 0; r < 4; ++r) {
            const int tk = 16 * w + 4 * fq + r;
            const float rg = fast_sigmoid(Racc[dt][r] + ba), ig = fast_sigmoid(Iacc[dt][r] + bx);
            const float a = __builtin_amdgcn_exp2f(rg * L2);
            float mult = sqrtf(fmaxf(1.0f - a * a, 0.f));
            if (MODE == 2 && tk == 0) mult = 1.0f;
            av[dt][r] = a; bv[dt][r] = mult * ig * XCF[tk * XCF_STRIDE + 16 * dt + fr];
        }
    }
    float Pex[4], Hex[4];
    float Pw[4], Hw[4];
#pragma unroll
    for (int dt = 0; dt < 4; ++dt) {
        float p = av[dt][0], h = bv[dt][0];
#pragma unroll
        for (int r = 1; r < 4; ++r) { h = av[dt][r] * h + bv[dt][r]; p *= av[dt][r]; }
        float p1 = __shfl(p, lane - 16), h1 = __shfl(h, lane - 16);
        float pi = p, hi = h;
        if (fq >= 1) { hi = p * h1 + h; pi = p1 * p; }
        float p2 = __shfl(pi, lane - 32), h2 = __shfl(hi, lane - 32);
        float pi2 = pi, hi2 = hi;
        if (fq >= 2) { hi2 = pi * h2 + hi; pi2 = p2 * pi; }
        const float pe = __shfl(pi2, lane - 16), he = __shfl(hi2, lane - 16);
        if (MODE == 1) {
            Pex[dt] = (fq & 1) ? p1 : 1.f; Hex[dt] = (fq & 1) ? h1 : 0.f;
        } else { Pex[dt] = (fq >= 1) ? pe : 1.f; Hex[dt] = (fq >= 1) ? he : 0.f; }
        Pw[dt] = __shfl(pi2, fr + 48); Hw[dt] = __shfl(hi2, fr + 48);
    }
    float hc[4];
    if (MODE == 1) {
        const int bseq = idx * 16 + 2 * w + (fq >> 1);
#pragma unroll
        for (int dt = 0; dt < 4; ++dt) hc[dt] = P.in[3][(size_t)bseq * LW + n * 64 + 16 * dt + fr];
    } else {
        if (fq == 0) {
#pragma unroll
            for (int dt = 0; dt < 4; ++dt) { WT[(w * 64 + 16 * dt + fr) * 2] = Pw[dt]; WT[(w * 64 + 16 * dt + fr) * 2 + 1] = Hw[dt]; }
        }
        __syncthreads();
        if (!FINAL) {
            if (tid < 64) {
                float p = 1.f, h = 0.f;
                const int nw = (MODE == 2) ? 1 : 8;
#pragma unroll
                for (int ww = 0; ww < 8; ++ww) if (ww < nw) { const float pw = WT[(ww * 64 + tid) * 2], hw = WT[(ww * 64 + tid) * 2 + 1]; h = pw * h + hw; p *= pw; }
                float* dst = (MODE == 2) ? SUMMETA + n * 128 : SUMM + ((size_t)(b * 16 + c) * 16 + n) * 128;
                dst[tid] = p; dst[64 + tid] = h;
            }
            return;
        }
#pragma unroll
        for (int dt = 0; dt < 4; ++dt) {
            float h = HIN[16 * dt + fr];
#pragma unroll
            for (int ww = 0; ww < 7; ++ww) if (ww < w) h = WT[(ww * 64 + 16 * dt + fr) * 2] * h + WT[(ww * 64 + 16 * dt + fr) * 2 + 1];
            hc[dt] = h;
        }
    }
    if (!FINAL) return;
#pragma unroll
    for (int dt = 0; dt < 4; ++dt) {
        float h = Pex[dt] * hc[dt] + Hex[dt];
#pragma unroll
        for (int r = 0; r < 4; ++r) { h = av[dt][r] * h + bv[dt][r]; XCF[(16 * w + 4 * fq + r) * XCF_STRIDE + 16 * dt + fr] = h; }
        if (MODE == 0 && c == 15 && w == 7 && fq == 3) P.out[O_NLP + (size_t)b * LW + n * 64 + 16 * dt + fr] = h;
        if (MODE == 1 && (fq & 1)) P.out[O_NLS + (size_t)(idx * 16 + 2 * w + (fq >> 1)) * LW + n * 64 + 16 * dt + fr] = h;
    }
    __syncthreads();
    {
        const LAS f32x4* f = (const LAS f32x4*)(XCF + t * XCF_STRIDE + cg * 16);
        float g[16];
#pragma unroll
        for (int q = 0; q < 4; ++q) { g[2 * q] = bf2f(gav[0][q] & 0xffffu); g[2 * q + 1] = bf2f(gav[0][q] >> 16); g[8 + 2 * q] = bf2f(gav[1][q] & 0xffffu); g[8 + 2 * q + 1] = bf2f(gav[1][q] >> 16); }
        u32x4 o0, o1; f32x4 h0 = f[0], h1 = f[1], h2 = f[2], h3 = f[3];
        o0.x = pk2(h0[0] * g[0], h0[1] * g[1]); o0.y = pk2(h0[2] * g[2], h0[3] * g[3]); o0.z = pk2(h1[0] * g[4], h1[1] * g[5]); o0.w = pk2(h1[2] * g[6], h1[3] * g[7]);
        o1.x = pk2(h2[0] * g[8], h2[1] * g[9]); o1.y = pk2(h2[2] * g[10], h2[3] * g[11]); o1.z = pk2(h3[0] * g[12], h3[1] * g[13]); o1.w = pk2(h3[2] * g[14], h3[3] * g[15]);
        u32x4* yp = (u32x4*)(YA + (size_t)(r0 + t) * LW + ch0); yp[0] = o0; yp[1] = o1;
    }
}
__device__ __forceinline__ void p2a_lru(const Ctx& C, const Params& P) {
    constexpr int NP = NB * 16 * NBLK, NS = 8 * NBLK, NM = NBLK;
    for (int item = C.vcu; item < NP + NS + NM; item += C.G) {
        if (item < NP) lru_tile<0, false>(C, P, item & 15, item >> 4);
        else if (item < NP + NS) lru_tile<1, true>(C, P, (item - NP) & 15, (item - NP) >> 4);
        else lru_tile<2, false>(C, P, item - NP - NS, 0);
    }
    __syncthreads();
}
__device__ __forceinline__ void p2b_lru(const Ctx& C, const Params& P) {
    constexpr int NP = NB * 16 * NBLK;
    for (int item = C.vcu; item < NP; item += C.G) lru_tile<0, true>(C, P, item & 15, item >> 4);
    __syncthreads();
}

constexpr int RT_STRIDE = 288;
constexpr size_t WS_KVT = WS_H;
constexpr size_t WS_KVMETA = WS_H + 32 * MiB;
__device__ __forceinline__ v4i16_t tr_read(const LAS unsigned char* p) { return __builtin_amdgcn_ds_read_tr16_b64_v4i16((LAS v4i16_t*)p); }
__device__ __forceinline__ bf16x8 cat44(v4i16_t a, v4i16_t b) { return (bf16x8){a[0], a[1], a[2], a[3], b[0], b[1], b[2], b[3]}; }
__device__ __forceinline__ void stage_tile(const Ctx& C, LAS unsigned char* dst, const bf16_t* src, int nvalid) {
    const int m = C.tid >> 2, q = C.tid & 3;
    const u32x4* g = (const u32x4*)(src + (size_t)m * 1024) + q * 4;
    u32x4 v[4];
#pragma unroll
    for (int i = 0; i < 4; ++i) v[i] = (m < nvalid) ? g[i] : (u32x4){0u, 0u, 0u, 0u};
    LAS u32x4* d = (LAS u32x4*)(dst + m * RT_STRIDE + q * 64);
#pragma unroll
    for (int i = 0; i < 4; ++i) d[i] = v[i];
}
__device__ __forceinline__ void ret_kv_item(const Ctx& C, const Params& P, int item) {
    unsigned char* ws = P.ws;
    const bf16_t* K = (const bf16_t*)(ws + WS_K); const bf16_t* V = (const bf16_t*)(ws + WS_V);
    const bool meta = item >= NB * 16 * RH;
    const int h = item & 7, bc = item >> 3;
    const int r0 = meta ? MROW_META : bc * 128;
    float* dst = meta ? (float*)(ws + WS_KVMETA) + (size_t)h * 16384 : (float*)(ws + WS_KVT) + ((size_t)bc * RH + h) * 16384;
    LAS unsigned char* KT = C.lds; LAS unsigned char* VT = C.lds + 128 * RT_STRIDE;
    __syncthreads();
    stage_tile(C, KT, K + (size_t)r0 * 1024 + h * 128, meta ? 16 : 128);
    stage_tile(C, VT, V + (size_t)r0 * 1024 + h * 128, meta ? 16 : 128);
    __syncthreads();
    const int lane = C.lane, w = C.wave, fr = lane & 15, fq = lane >> 4, q = fr >> 2, p = fr & 3;
    const int lofs = q * RT_STRIDE + p * 8;
    bf16x8 af[4];
#pragma unroll
    for (int ks = 0; ks < 4; ++ks) {
        const LAS unsigned char* a0 = VT + (32 * ks + 8 * fq) * RT_STRIDE + (16 * w) * 2 + lofs;
        af[ks] = cat44(tr_read(a0), tr_read(a0 + 4 * RT_STRIDE));
    }
#pragma unroll
    for (int dt = 0; dt < 8; ++dt) {
        f32x4 acc = (f32x4){0.f, 0.f, 0.f, 0.f};
#pragma unroll
        for (int ks = 0; ks < 4; ++ks) {
            const LAS unsigned char* b0 = KT + (32 * ks + 8 * fq) * RT_STRIDE + (16 * dt) * 2 + lofs;
            const bf16x8 bf = cat44(tr_read(b0), tr_read(b0 + 4 * RT_STRIDE));
            acc = __builtin_amdgcn_mfma_f32_16x16x32_bf16(af[ks], bf, acc, 0, 0, 0);
        }
#pragma unroll
        for (int r = 0; r < 4; ++r) dst[(16 * w + 4 * fq + r) * 128 + 16 * dt + fr] = acc[r];
    }
}
__device__ __forceinline__ void ret_prefix_item(const Ctx& C, const Params& P, int item) {
    unsigned char* ws = P.ws;
    const int bh = item >> 3, vs = item & 7, b = bh >> 3, h = bh & 7;
    const int v = 16 * vs + (C.tid >> 5), d4 = (C.tid & 31) * 4, e = v * 128 + d4;
    const float* KVT = (const float*)(ws + WS_KVT); const float* KVM = (const float*)(ws + WS_KVMETA);
    bf16_t* SPT = (bf16_t*)P.out;
    const float lg = lg2gamma(h), g16 = __builtin_amdgcn_exp2f(16.f * lg), g128 = __builtin_amdgcn_exp2f(128.f * lg);
    f32x4 kv[16];
#pragma unroll
    for (int c = 0; c < 16; ++c) kv[c] = *(const f32x4*)(KVT + ((size_t)(b * 16 + c) * RH + h) * 16384 + e);
    f32x4 carry = *(const f32x4*)(KVM + (size_t)h * 16384 + e) * g16;
#pragma unroll
    for (int c = 0; c < 16; ++c) {
        u32x2 wv; wv.x = pk2(carry[0], carry[1]); wv.y = pk2(carry[2], carry[3]);
        *(u32x2*)(SPT + ((size_t)(b * 16 + c) * RH + h) * 16384 + e) = wv;
        carry = (carry + kv[c]) * g128;
    }
    LAS float* tl = (LAS float*)C.lds;
    __syncthreads();
    *(LAS f32x4*)(tl + (C.tid >> 5) * 132 + d4) = carry;
    __syncthreads();
    const int d = C.tid >> 2, v4 = (C.tid & 3) * 4;
    const f32x4 o = (f32x4){tl[(v4 + 0) * 132 + d], tl[(v4 + 1) * 132 + d], tl[(v4 + 2) * 132 + d], tl[(v4 + 3) * 132 + d]};
    *(f32x4*)(P.out + O_NRP + ((size_t)bh * 128 + d) * 128 + 16 * vs + v4) = o;
}
__device__ __forceinline__ void ret_out_item(const Ctx& C, const Params& P, int item) {
    unsigned char* ws = P.ws;
    const bf16_t* Q = (const bf16_t*)(ws + WS_Q); const bf16_t* K = (const bf16_t*)(ws + WS_K); const bf16_t* V = (const bf16_t*)(ws + WS_V); const bf16_t* G = (const bf16_t*)(ws + WS_G);
    bf16_t* YB = (bf16_t*)(ws + WS_YB);
    const int h = item & 7, bc = item >> 3, r0 = bc * 128;
    const bf16_t* SPT = (const bf16_t*)P.out + ((size_t)bc * RH + h) * 16384;
    LAS unsigned char* VT = C.lds;
    __syncthreads();
    stage_tile(C, VT, V + (size_t)r0 * 1024 + h * 128, 128);
    const int lane = C.lane, w = C.wave, fr = lane & 15, fq = lane >> 4, q = fr >> 2, p = fr & 3;
    const int lofs = q * RT_STRIDE + p * 8;
    const size_t hoff = (size_t)h * 128;
    bf16x8 qf[4];
#pragma unroll
    for (int ks = 0; ks < 4; ++ks) qf[ks] = *(const bf16x8*)(Q + (size_t)(r0 + 16 * w + fr) * 1024 + hoff + 32 * ks + 8 * fq);
    u32x2 X[8];
#pragma unroll
    for (int mt = 0; mt < 8; ++mt) {
        X[mt] = (u32x2){0u, 0u};
        if (mt <= w) {
            f32x4 acc = (f32x4){0.f, 0.f, 0.f, 0.f};
#pragma unroll
            for (int ks = 0; ks < 4; ++ks) {
                const bf16x8 kf = *(const bf16x8*)(K + (size_t)(r0 + 16 * mt + fr) * 1024 + hoff + 32 * ks + 8 * fq);
                acc = __builtin_amdgcn_mfma_f32_16x16x32_bf16(kf, qf[ks], acc, 0, 0, 0);
            }
            if (mt == w) {
#pragma unroll
                for (int r = 0; r < 4; ++r) acc[r] = (4 * fq + r <= fr) ? acc[r] : 0.f;
            }
            X[mt].x = pk2(acc[0], acc[1]); X[mt].y = pk2(acc[2], acc[3]);
        }
    }
    __syncthreads();
    f32x4 O[8];
#pragma unroll
    for (int vt = 0; vt < 8; ++vt) {
        f32x4 acc = (f32x4){0.f, 0.f, 0.f, 0.f};
#pragma unroll
        for (int ks = 0; ks < 4; ++ks) {
            const bf16x8 sf = *(const bf16x8*)(SPT + (size_t)(16 * vt + fr) * 128 + 32 * ks + 8 * fq);
            acc = __builtin_amdgcn_mfma_f32_16x16x32_bf16(sf, qf[ks], acc, 0, 0, 0);
        }
#pragma unroll
        for (int kk = 0; kk < 4; ++kk) {
            if (2 * kk <= w) {
                const LAS unsigned char* a0 = VT + (32 * kk + 4 * fq) * RT_STRIDE + (16 * vt) * 2 + lofs;
                const bf16x8 vf = cat44(tr_read(a0), tr_read(a0 + 16 * RT_STRIDE));
                bf16x8 xf; { u32x4 t4; t4.x = X[2 * kk].x; t4.y = X[2 * kk].y; t4.z = X[2 * kk + 1].x; t4.w = X[2 * kk + 1].y; xf = __builtin_bit_cast(bf16x8, t4); }
                acc = __builtin_amdgcn_mfma_f32_16x16x32_bf16(vf, xf, acc, 0, 0, 0);
            }
        }
        O[vt] = acc;
    }
    float s = 0.f;
#pragma unroll
    for (int vt = 0; vt < 8; ++vt) s += (O[vt][0] + O[vt][1]) + (O[vt][2] + O[vt][3]);
    s += __shfl_xor(s, 16); s += __shfl_xor(s, 32);
    const float mu = s * (1.f / 128.f);
    float qv = 0.f;
#pragma unroll
    for (int vt = 0; vt < 8; ++vt) { const f32x4 dd = O[vt] - mu; qv += (dd[0] * dd[0] + dd[1] * dd[1]) + (dd[2] * dd[2] + dd[3] * dd[3]); }
    qv += __shfl_xor(qv, 16); qv += __shfl_xor(qv, 32);
    const float rstd = 1.0f / sqrtf(qv * (1.f / 128.f) + EPS);
    const size_t rowoff = (size_t)(r0 + 16 * w + fr) * 1024 + hoff;
#pragma unroll
    for (int vt = 0; vt < 8; ++vt) {
        const int vv = 16 * vt + 4 * fq;
        const f32x4 gnv = *(const f32x4*)(P.in[15] + hoff + vv);
        const u32x2 gg = *(const u32x2*)(G + rowoff + vv);
        const f32x4 y = (O[vt] - mu) * rstd * gnv;
        u32x2 o; o.x = pk2(y[0] * bf2f(gg.x & 0xffffu), y[1] * bf2f(gg.x >> 16)); o.y = pk2(y[2] * bf2f(gg.y & 0xffffu), y[3] * bf2f(gg.y >> 16));
        *(u32x2*)(YB + rowoff + vv) = o;
    }
}
__device__ __forceinline__ void ret_sample_item(const Ctx& C, const Params& P, int item) {
    unsigned char* ws = P.ws;
    const bf16_t* Q = (const bf16_t*)(ws + WS_Q); const bf16_t* K = (const bf16_t*)(ws + WS_K); const bf16_t* V = (const bf16_t*)(ws + WS_V); const bf16_t* G = (const bf16_t*)(ws + WS_G);
    bf16_t* YB = (bf16_t*)(ws + WS_YB);
    const int b = item >> 3, h = item & 7, rb = MP + b * 8;
    LAS float* qs = (LAS float*)C.lds; LAS float* ks = qs + 1024; LAS float* vs = ks + 1024; LAS float* scs = vs + 1024; LAS float* red = scs + 64;
    const int tid = C.tid, v4 = (tid & 31) * 4, dg = tid >> 5;
    const float* S0 = P.in[4] + ((size_t)(b * RH + h) * 128) * 128;
    f32x4 sv[8];
#pragma unroll
    for (int j = 0; j < 8; ++j) sv[j] = *(const f32x4*)(S0 + (size_t)(dg + 16 * j) * 128 + v4);
    __syncthreads();
#pragma unroll
    for (int k = 0; k < 6; ++k) { const int idx = tid + 512 * k, arr = idx >> 10, tok = (idx >> 7) & 7, e = idx & 127;
        const bf16_t* src = (arr == 0) ? Q : (arr == 1) ? K : V;
        qs[idx] = bf2f(src[(size_t)(rb + tok) * 1024 + h * 128 + e]); }
    __syncthreads();
    { const int pair = tid >> 3, part = tid & 7, t = pair >> 3, m = pair & 7; float a = 0.f;
#pragma unroll
      for (int i = 0; i < 16; ++i) a += qs[t * 128 + part * 16 + i] * ks[m * 128 + part * 16 + i];
      a += __shfl_xor(a, 1); a += __shfl_xor(a, 2); a += __shfl_xor(a, 4);
      if (part == 0) scs[pair] = (m <= t) ? a : 0.f; }
    f32x4 vv[8];
#pragma unroll
    for (int m = 0; m < 8; ++m) vv[m] = *(const LAS f32x4*)(vs + m * 128 + v4);
    f32x4 po[8];
#pragma unroll
    for (int t = 0; t < 8; ++t) po[t] = (f32x4){0.f, 0.f, 0.f, 0.f};
    const float g8 = __builtin_amdgcn_exp2f(8.f * lg2gamma(h));
    float* Sn = P.out + O_NRS + ((size_t)(b * RH + h) * 128) * 128;
#pragma unroll
    for (int j = 0; j < 8; ++j) {
        const int d = dg + 16 * j;
        f32x4 sn = sv[j];
#pragma unroll
        for (int t = 0; t < 8; ++t) po[t] += sv[j] * qs[t * 128 + d];
#pragma unroll
        for (int m = 0; m < 8; ++m) sn += vv[m] * ks[m * 128 + d];
        *(f32x4*)(Sn + (size_t)d * 128 + v4) = sn * g8;
    }
#pragma unroll
    for (int t = 0; t < 8; ++t) *(LAS f32x4*)(red + (dg * 8 + t) * 128 + v4) = po[t];
    __syncthreads();
    { const int t = tid >> 6, v2 = (tid & 63) * 2;
      float o0 = 0.f, o1 = 0.f;
#pragma unroll
      for (int g = 0; g < 16; ++g) { const f32x2 r = *(const LAS f32x2*)(red + (g * 8 + t) * 128 + v2); o0 += r[0]; o1 += r[1]; }
#pragma unroll
      for (int m = 0; m < 8; ++m) { const float sc = scs[t * 8 + m]; const f32x2 r = *(const LAS f32x2*)(vs + m * 128 + v2); o0 += sc * r[0]; o1 += sc * r[1]; }
      const float mu = wave_sum(o0 + o1) * (1.f / 128.f);
      const float d0 = o0 - mu, d1 = o1 - mu;
      const float rstd = 1.0f / sqrtf(wave_sum(d0 * d0 + d1 * d1) * (1.f / 128.f) + EPS);
      const size_t off = (size_t)(rb + t) * 1024 + h * 128 + v2;
      const unsigned gg = *(const unsigned*)(G + off);
      const f32x2 gnv = *(const f32x2*)(P.in[15] + h * 128 + v2);
      *(unsigned*)(YB + off) = pk2(d0 * rstd * gnv[0] * bf2f(gg & 0xffffu), d1 * rstd * gnv[1] * bf2f(gg >> 16)); }
}
__device__ __forceinline__ void p2a_ret(const Ctx& C, const Params& P) {
    for (int item = C.vcu; item < NB * 16 * RH + RH; item += C.G) ret_kv_item(C, P, item);
    __syncthreads();
}
__device__ __forceinline__ void p2m_ret(const Ctx& C, const Params& P) {
    for (int item = C.vcu; item < NB * RH * 8; item += C.G) ret_prefix_item(C, P, item);
    for (int item = C.vcu; item < DECB * RH; item += C.G) ret_sample_item(C, P, item);
    __syncthreads();
}
__device__ __forceinline__ void p2b_ret(const Ctx& C, const Params& P) {
    for (int item = C.vcu; item < NB * 16 * RH; item += C.G) ret_out_item(C, P, item);
    __syncthreads();
}
__device__ __forceinline__ void p7_final_norm(const Ctx& C, const Params& P) {
    const float* ss2 = (const float*)(P.ws + WS_SS) + M; const float* gf = P.in[22];
    const int gw = C.vcu * NWAVES + C.wave, NGW = C.G * NWAVES;
    for (int m = gw; m < M; m += NGW) {
        const float rstd = 1.0f / sqrtf(__hip_atomic_load(ss2 + m, __ATOMIC_RELAXED, __HIP_MEMORY_SCOPE_AGENT) * (1.f / DM) + EPS);
        f32x4* xr = (f32x4*)(P.out + (size_t)m * DM) + C.lane; const f32x4* gr = (const f32x4*)gf + C.lane;
#pragma unroll
        for (int j = 0; j < 8; ++j) { f32x4 x = xr[64 * j]; x = x * rstd * gr[64 * j]; xr[64 * j] = x; }
    }
}

constexpr int NPHASE = 11;
__global__ void __launch_bounds__(NTHR, 2) mega_fwd(Params P) {
    extern __shared__ __attribute__((aligned(16))) unsigned char lds_raw[];
    Ctx C;
    C.lds = (LAS unsigned char*)lds_raw;
    C.tid = threadIdx.x; C.lane = C.tid & 63; C.wave = __builtin_amdgcn_readfirstlane(C.tid >> 6);
    C.G = gridDim.x; { const int bx = blockIdx.x; C.vcu = (C.G % 8 == 0) ? (bx % 8) * (C.G / 8) + bx / 8 : bx; }
    volatile LAS unsigned* MISC = (volatile LAS unsigned*)(C.lds + MISC_OFF);
    for (int u = C.tid; u < (LDS_BYTES - LDSCTL_OFF) / 4; u += NTHR) ((LAS unsigned*)(C.lds + LDSCTL_OFF))[u] = 0u;
    __syncthreads();
    unsigned char* ws = P.ws;
    XcdBarrier bar; bar.bar = (unsigned*)(ws + WS_CTL) + CW_BAR; bar.x = 0; bar.st = nullptr;
    const bool one_launch = (P.ph_hi - P.ph_lo) > 1;
    if (one_launch) bar = xcd_barrier_post((unsigned*)(ws + WS_CTL) + CW_BAR, MISC + 8);
    const int lo = P.ph_lo, hi = P.ph_hi;
#define IN(k) (lo <= (k) && (k) < hi)
#define SEAM(k) do { if (IN(k) && IN((k) + 1)) xcd_barrier(bar); } while (0)
    float* Aarr = P.out; float* Barr = P.out + (size_t)M * LW;
    float* T = P.out;
    if (IN(0)) { p0_prep(C, P); } SEAM(0);
    if (IN(1)) {
        pg8::TileOrder S; S.init(37, 40, C.G, (int)blockIdx.x);
        EpiProj E{(bf16_t*)(ws + WS_XA), (bf16_t*)(ws + WS_GA), (bf16_t*)(ws + WS_Q), (bf16_t*)(ws + WS_K), (bf16_t*)(ws + WS_V), (bf16_t*)(ws + WS_G), (bf16_t*)(ws + WS_SA), (bf16_t*)(ws + WS_SB),
                  (const float*)(ws + WS_TAB), (const float*)(ws + WS_TAB) + TABROWS * 64};
        pg8::gemm_phase<EpiProj, true, true>(C.lds, (const bf16_t*)(ws + WS_H), (const bf16_t*)(ws + WS_WIN), DM, S, E);
    } SEAM(1);
    if (IN(2)) { p2a_lru(C, P); p2a_ret(C, P); } SEAM(2);
    if (IN(3)) { p2m_ret(C, P); } SEAM(3);
    if (IN(4)) { p2b_lru(C, P); p2b_ret(C, P); } SEAM(4);
    if (IN(5)) {
        pg8::TileOrder S; S.init(36, 8, C.G, (int)blockIdx.x);
        EpiMergeA E{(const bf16_t*)(ws + WS_SA), T};
        pg8::gemm_phase<EpiMergeA, true, true>(C.lds, (const bf16_t*)(ws + WS_YA), (const bf16_t*)(ws + WS_PA), LW, S, E);
    } SEAM(5);
    if (IN(6)) {
        pg8::TileOrder S; S.init(36, 8, C.G, (int)blockIdx.x);
        EpiMergeB E{(const bf16_t*)(ws + WS_SB), T, (bf16_t*)(ws + WS_MERGED)};
        pg8::gemm_phase<EpiMergeB, true, true>(C.lds, (const bf16_t*)(ws + WS_YB), (const bf16_t*)(ws + WS_PB), LW, S, E);
    } SEAM(6);
    if (IN(7)) {
        pg8::TileOrder S; S.init(36, 8, C.G, (int)blockIdx.x);
        EpiRes1 E{P.in[0], P.in[1], P.out, (bf16_t*)(ws + WS_X1N), P.in[19], (float*)(ws + WS_SS)};
        pg8::gemm_phase<EpiRes1, true, true>(C.lds, (const bf16_t*)(ws + WS_MERGED), (const bf16_t*)(ws + WS_WOUT), DM, S, E);
    } SEAM(7);
    if (IN(8)) {
        pg8::TileOrder S; S.init(36, 32, C.G, (int)blockIdx.x);
        EpiUp E{(const float*)(ws + WS_SS), (bf16_t*)(ws + WS_U)};
        pg8::gemm_phase<EpiUp, true, true>(C.lds, (const bf16_t*)(ws + WS_X1N), (const bf16_t*)(ws + WS_WUP), DM, S, E);
    } SEAM(8);
    if (IN(9)) {
        pg8::TileOrder S; S.init(36, 8, C.G, (int)blockIdx.x);
        EpiDown E{P.out, (float*)(ws + WS_SS) + M};
        pg8::gemm_phase<EpiDown, true, true>(C.lds, (const bf16_t*)(ws + WS_U), (const bf16_t*)(ws + WS_WDN), DFF, S, E);
    } SEAM(9);
    if (IN(10)) { p7_final_norm(C, P); }
#undef IN
#undef SEAM
}

extern "C" void kernel_launch(void* const* d_in, const int* in_sizes, int n_in, void* d_out, int out_size, void* d_ws, size_t ws_size, hipStream_t stream) {
    static int grid = 0;
    if (grid == 0) {
        if (n_in != 23 || (size_t)out_size != O_END || ws_size < WS_END) { fprintf(stderr, "kernel_launch: unexpected sizes n_in %d out %d ws %zu (need %zu)\n", n_in, out_size, ws_size, (size_t)WS_END); grid = -1; return; }
        int dev = 0, cus = 0, per_cu = 0;
        if (hipGetDevice(&dev) != hipSuccess || hipDeviceGetAttribute(&cus, hipDeviceAttributeMultiprocessorCount, dev) != hipSuccess) { grid = -1; return; }
        if (hipFuncSetAttribute((const void*)mega_fwd, hipFuncAttributeMaxDynamicSharedMemorySize, LDS_BYTES) != hipSuccess) { fprintf(stderr, "kernel_launch: hipFuncSetAttribute failed\n"); grid = -1; return; }
        if (hipOccupancyMaxActiveBlocksPerMultiprocessor(&per_cu, (const void*)mega_fwd, NTHR, LDS_BYTES) != hipSuccess || per_cu < 1) { fprintf(stderr, "kernel_launch: occupancy query says %d blocks per CU\n", per_cu); (void)hipGetLastError(); grid = -1; return; }
        grid = cus;
    }
    if (grid < 0) return;
    if (hipMemsetAsync((char*)d_ws + WS_CTL, 0, CTL_ZERO_BYTES, stream) != hipSuccess) return;
    Params a{};
    for (int i = 0; i < 23; ++i) a.in[i] = (const float*)d_in[i];
    a.out = (float*)d_out; a.ws = (unsigned char*)d_ws;
#if MK_N_LAUNCHES == 1
    a.ph_lo = 0; a.ph_hi = NPHASE; a.li = 0;
    hipLaunchKernelGGL(mega_fwd, dim3(grid), dim3(NTHR), LDS_BYTES, stream, a);
#else
    for (int li = 0; li < NPHASE; ++li) { a.ph_lo = li; a.ph_hi = li + 1; a.li = li; hipLaunchKernelGGL(mega_fwd, dim3(grid), dim3(NTHR), LDS_BYTES, stream, a); }
#endif
}
```

```cpp
#include <hip/hip_runtime.h>
#include <cstdio>
#include <cstdint>

#ifndef MK_N_LAUNCHES
#define MK_N_LAUNCHES 1
#endif

#define LAS __attribute__((address_space(3)))
#define GAS __attribute__((address_space(1)))
typedef unsigned short bf16_t;
typedef short bf16x8 __attribute__((ext_vector_type(8)));
typedef float f32x4 __attribute__((ext_vector_type(4)));
typedef float f32x2 __attribute__((ext_vector_type(2)));
typedef unsigned u32x4 __attribute__((ext_vector_type(4)));
typedef unsigned u32x2 __attribute__((ext_vector_type(2)));
typedef GAS unsigned gu32;

constexpr int DM = 2048, NB = 4, SEQ = 2048, DECB = 128, DECS = 8, NMETA = 16;
constexpr int LW = 1024, NBLK = 16, BLK = 64, RH = 8, DK = 128, DFF = 8192, DPROJ = 10240;
constexpr int MP = NB * SEQ;
constexpr int MS = DECB * DECS;
constexpr int M = MP + MS;
constexpr int MROW_META = M;
constexpr int M1 = M + NMETA;
constexpr int M1PAD = 9472;
constexpr float EPS = 1e-6f;
constexpr int TABROWS = 2064 + 8;

constexpr size_t O_YP = 0, O_YS = 16777216, O_NCP = 18874368, O_NLP = 18886656, O_NRP = 18890752, O_NCS = 19415040, O_NLS = 19808256, O_NRS = 19939328, O_END = 36716544;

constexpr size_t MiB = 1u << 20;
constexpr size_t WS_CTL = 0, CTL_ZERO_BYTES = 1 * MiB;
constexpr size_t WS_TAB = 1 * MiB;
constexpr size_t WS_SS = 3 * MiB;
constexpr size_t WS_METAAB = 3 * MiB + 256 * 1024;
constexpr size_t WS_LRUW = 3 * MiB + 512 * 1024;
constexpr size_t WS_SUMM = 2 * MiB + 256 * 1024;
constexpr size_t WS_SUMMETA = WS_SUMM + 512 * 1024;
constexpr size_t WS_WIN = 4 * MiB;
constexpr size_t WS_WUP = 44 * MiB, WS_WDN = 76 * MiB, WS_WOUT = 108 * MiB, WS_PA = 116 * MiB, WS_PB = 120 * MiB;
constexpr size_t WS_H = 124 * MiB;
constexpr size_t WS_XA = 161 * MiB;
constexpr size_t SZ_P1 = (size_t)M1PAD * 1024 * 2;
constexpr size_t WS_GA = WS_XA + SZ_P1, WS_Q = WS_GA + SZ_P1, WS_K = WS_Q + SZ_P1, WS_V = WS_K + SZ_P1, WS_G = WS_V + SZ_P1, WS_SA = WS_G + SZ_P1, WS_SB = WS_SA + 2 * SZ_P1;
constexpr size_t WS_END = WS_SB + 2 * SZ_P1;
constexpr size_t WS_YAB = WS_WIN;
constexpr size_t WS_X1N = WS_WIN, WS_MERGED = WS_SB  , WS_U = WS_H  , WS_SLAB1 = WS_SA  ;
static_assert(WS_END == 346 * MiB, "ws map");
static_assert(WS_U + (size_t)M * DFF * 2 <= WS_SA && WS_SLAB1 + (size_t)M * DM * 4 <= WS_END, "overlays");
constexpr int CW_BAR = 4096;

__device__ __forceinline__ float bf2f(unsigned b) { return __uint_as_float(b << 16); }
__device__ __forceinline__ unsigned f2bf(float f) { unsigned u = __float_as_uint(f); return (u + 0x7fffu + ((u >> 16) & 1u)) >> 16; }
__device__ __forceinline__ unsigned pk2(float lo, float hi) { return f2bf(lo) | (f2bf(hi) << 16); }
__device__ __forceinline__ unsigned cvt_pk_bf16(float lo, float hi) { unsigned r; asm volatile("v_cvt_pk_bf16_f32 %0, %1, %2" : "=v"(r) : "v"(lo), "v"(hi)); return r; }
__device__ __forceinline__ float fast_sigmoid(float x) { return __builtin_amdgcn_rcpf(1.0f + __builtin_amdgcn_exp2f(-1.4426950409f * x)); }
__device__ __forceinline__ float gelu_tanh(float x) { const float u = 1.5957691216f * (x + 0.044715f * x * x * x); return x * fast_sigmoid(u); }
__device__ __forceinline__ float silu_f(float x) { return x * fast_sigmoid(x); }
__device__ __forceinline__ float wave_sum(float v) {
#pragma unroll
    for (int o = 1; o < 64; o <<= 1) v += __shfl_xor(v, o);
    return v;
}
#define LDS_WAIT() asm volatile("s_waitcnt lgkmcnt(0)" ::: "memory")
#define VM_WAIT() asm volatile("s_waitcnt vmcnt(0)" ::: "memory")

__device__ const double INVF[64] = {1.0, 0.8659643233600653, 0.7498942093324559, 0.6493816315762113, 0.5623413251903491, 0.4869675251658631, 0.4216965034285822, 0.3651741272548377, 0.31622776601683794, 0.27384196342643613, 0.23713737056616552, 0.2053525026457146, 0.1778279410038923, 0.1539926526059492, 0.1333521432163324, 0.11547819846894582, 0.1, 0.08659643233600653, 0.07498942093324558, 0.06493816315762113, 0.05623413251903491, 0.04869675251658631, 0.042169650342858224, 0.03651741272548377, 0.03162277660168379, 0.027384196342643614, 0.023713737056616554, 0.02053525026457146, 0.01778279410038923, 0.01539926526059492, 0.01333521432163324, 0.011547819846894581, 0.01, 0.008659643233600654, 0.007498942093324558, 0.006493816315762113, 0.005623413251903491, 0.004869675251658631, 0.004216965034285823, 0.003651741272548377, 0.0031622776601683794, 0.0027384196342643613, 0.0023713737056616554, 0.002053525026457146, 0.0017782794100389228, 0.001539926526059492, 0.001333521432163324, 0.0011547819846894581, 0.001, 0.0008659643233600654, 0.0007498942093324559, 0.0006493816315762113, 0.0005623413251903491, 0.0004869675251658631, 0.00042169650342858224, 0.0003651741272548377, 0.00031622776601683794, 0.0002738419634264361, 0.00023713737056616554, 0.0002053525026457146, 0.00017782794100389227, 0.0001539926526059492, 0.0001333521432163324, 0.00011547819846894582};
__device__ __forceinline__ float lg2gamma(int h) {
    const float t[8] = {-0.04580368961312479f, -0.02272007650008353f, -0.011315313227834146f, -0.005646563141142063f, -0.0028205190623786626f, -0.0014095702546713536f, -0.0007046129765893727f, -0.0003522634716290214f};
    float r = t[0];
#pragma unroll
    for (int i = 1; i < 8; ++i) r = (h == i) ? t[i] : r;
    return r;
}

namespace pg8 {
constexpr int BM = 256, BK = 64, HALF = 128, HTB = HALF * BK * 2, STAGE_BYTES = 8 * HTB, NXCD = 8, WGM = 8;
__device__ __forceinline__ int lds_byte(int r, int c) { const int st = (r >> 4) * 2 + (c >> 5), rr = r & 15, cc = c & 31, ob = rr * 64 + cc * 2; return st * 1024 + (ob ^ (((ob >> 9) & 1) << 5)); }
__device__ __forceinline__ void stage_rc(int b, int& R, int& C) { const int st = b / 1024, sb = b % 1024, swz = sb ^ (((sb >> 9) & 1) << 5); R = (st >> 1) * 16 + swz / 64; C = (st & 1) * 32 + (swz % 64) / 2; }
__device__ __forceinline__ int perm32(int rho) { const int n = rho >> 4, i = rho & 15; return 8 * (i >> 2) + 4 * n + (i & 3); }
__device__ __forceinline__ int brow_perm(int R, int kind) {
    if (kind == 0) return (R & ~31) + perm32(R & 31);
    if (kind == 1) return ((R >> 5) << 4) + (R & 15) + (((R >> 4) & 1) << 6);
    return R;
}
struct Unit { int pm, pn; };
struct TileOrder {
    int nM, nN, nwg, G, c;
    __device__ void init(int nM_, int nN_, int G_, int c_) { nM = nM_; nN = nN_; nwg = nM * nN; G = G_; c = c_; }
    __device__ bool next(int i, Unit& u) const {
        const long L = (long)i * G + c; if (L >= nwg) return false;
        int wgid = (int)L; { const int q = nwg / NXCD, r = nwg % NXCD, xcd = wgid % NXCD, off = wgid / NXCD; wgid = (xcd < r ? xcd * (q + 1) : r * (q + 1) + (xcd - r) * q) + off; }
        const int nig = WGM * nN, gid = wgid / nig, fm = gid * WGM, gsz = (nM - fm) < WGM ? (nM - fm) : WGM;
        u.pm = fm + ((wgid % nig) % gsz); u.pn = (wgid % nig) / gsz; return true;
    }
};

template <class Epi, bool ALIGN_EPI, bool SP2>
__device__ __forceinline__ void gemm_phase(LAS unsigned char* lds, const bf16_t* Ag, const bf16_t* Btg, const int K, const TileOrder& S, const Epi& E) {
    const int tid = threadIdx.x, wid = __builtin_amdgcn_readfirstlane(tid >> 6), lane = tid & 63, wr = wid >> 2, wc = wid & 3, fr = lane & 15, fq = lane >> 4;
    const int nt = K / BK;
    int sR[2], sC[2];
    unsigned voffA[2], vBc[2], vBn[2];
#pragma unroll
    for (int i = 0; i < 2; ++i) { stage_rc(tid * 16 + i * 8192, sR[i], sC[i]); voffA[i] = (unsigned)(sR[i] * K + sC[i]) * 2u; }
    const size_t kstep = (size_t)(BK * 2);
    const size_t hstep = (size_t)HALF * K * 2;
    const size_t tstep = 2 * hstep;
    const unsigned ldsw = (unsigned)wid * 1024u;
    const int aoff = lds_byte(wr * 64 + fr, fq * 8), boff = lds_byte(wc * 32 + fr, fq * 8);
#define PG8_SA(b, h) (((b) * 2 + (h)) * HTB)
#define PG8_SB(b, h) ((4 + (b) * 2 + (h)) * HTB)
#define PG8_STAGE(bufoff, gbase, voff) do { _Pragma("unroll") for (int _i = 0; _i < 2; ++_i) \
        __builtin_amdgcn_global_load_lds((const unsigned*)((const char*)(gbase) + (voff)[_i]), (LAS unsigned*)(lds + (bufoff) + ldsw + _i * 8192), 16, 0, 0); } while (0)
#define PG8_LDA(dst, b, h) do { _Pragma("unroll") for (int m = 0; m < 4; ++m) _Pragma("unroll") for (int k = 0; k < 2; ++k) dst[m][k] = *(const LAS bf16x8*)(lds + PG8_SA(b, h) + aoff + m * 2048 + k * 1024); } while (0)
#define PG8_LDB(dst, b, h) do { _Pragma("unroll") for (int n = 0; n < 2; ++n) _Pragma("unroll") for (int k = 0; k < 2; ++k) dst[n][k] = *(const LAS bf16x8*)(lds + PG8_SB(b, h) + boff + n * 2048 + k * 1024); } while (0)
#define PG8_MMA(ai, bj, At, Bt) do { __builtin_amdgcn_s_setprio(1); _Pragma("unroll") for (int m = 0; m < 4; ++m) _Pragma("unroll") for (int n = 0; n < 2; ++n) _Pragma("unroll") for (int k = 0; k < 2; ++k) \
        acc[ai][bj][m][n] = __builtin_amdgcn_mfma_f32_16x16x32_bf16(Bt[n][k], At[m][k], acc[ai][bj][m][n], 0, 0, 0); __builtin_amdgcn_s_setprio(0); } while (0)
#define PG8_WAIT_V(n) asm volatile("s_waitcnt vmcnt(" #n ")" ::: "memory")
#define PG8_WAIT_L(n) asm volatile("s_waitcnt lgkmcnt(" #n ")" ::: "memory")
#define PG8_BAR __builtin_amdgcn_s_barrier()
#define PG8_SCHED __builtin_amdgcn_sched_barrier(0)
    Unit cur, nxt; int ui = 0;
    if (!S.next(0, cur)) return;
    { const int kind = E.bkind(cur);
#pragma unroll
      for (int i = 0; i < 2; ++i) { vBc[i] = (unsigned)(brow_perm(sR[i], kind) * K + sC[i]) * 2u; vBn[i] = vBc[i]; } }
    f32x4 acc[2][2][4][2];
#pragma unroll
    for (int a = 0; a < 2; ++a)
#pragma unroll
        for (int b = 0; b < 2; ++b)
#pragma unroll
            for (int m = 0; m < 4; ++m)
#pragma unroll
                for (int n = 0; n < 2; ++n) acc[a][b][m][n] = (f32x4){0.f, 0.f, 0.f, 0.f};
    bf16x8 At[4][2], B0[2][2], B1[2][2];
    const char* cA = (const char*)Ag + (size_t)cur.pm * tstep; const char* cB = (const char*)Btg + (size_t)cur.pn * tstep;
    if constexpr (SP2) {
        PG8_STAGE(PG8_SB(0, 0), cB, vBc); PG8_STAGE(PG8_SB(0, 1), cB + hstep, vBc); PG8_STAGE(PG8_SA(0, 0), cA, voffA); PG8_STAGE(PG8_SA(0, 1), cA + hstep, voffA);
        if (wr == 1) PG8_BAR;
        PG8_WAIT_V(2); PG8_BAR;
        PG8_STAGE(PG8_SB(1, 0), cB + kstep, vBc); PG8_STAGE(PG8_SA(1, 0), cA + kstep, voffA); PG8_STAGE(PG8_SB(1, 1), cB + hstep + kstep, vBc);
        PG8_WAIT_V(6); PG8_BAR;
    } else {
        PG8_STAGE(PG8_SB(0, 0), cB, vBc); PG8_STAGE(PG8_SA(0, 0), cA, voffA); PG8_STAGE(PG8_SB(0, 1), cB + hstep, vBc); PG8_STAGE(PG8_SA(0, 1), cA + hstep, voffA);
        if (wr == 1) PG8_BAR;
        PG8_WAIT_V(4); PG8_BAR;
        PG8_STAGE(PG8_SB(1, 0), cB + kstep, vBc); PG8_STAGE(PG8_SA(1, 0), cA + kstep, voffA); PG8_STAGE(PG8_SB(1, 1), cB + hstep + kstep, vBc);
        PG8_WAIT_V(6); PG8_BAR;
    }
    for (;;) {
        const bool has_next = S.next(ui + 1, nxt);
        const char* nA = has_next ? (const char*)Ag + (size_t)nxt.pm * tstep : cA; const char* nB = has_next ? (const char*)Btg + (size_t)nxt.pn * tstep : cB;
        if (has_next) { const int kind = E.bkind(nxt);
#pragma unroll
            for (int i = 0; i < 2; ++i) vBn[i] = (unsigned)(brow_perm(sR[i], kind) * K + sC[i]) * 2u; }
        for (int t = 0; t < nt; t += 2) {
            const bool last = (t == nt - 2);
            const char* a1 = cA + (size_t)(t + 1) * kstep;
            const char* a2 = last ? nA : cA + (size_t)(t + 2) * kstep; const char* b2 = last ? nB : cB + (size_t)(t + 2) * kstep;
            const char* a3 = a2 + kstep; const char* b3 = b2 + kstep;
            unsigned vB[2]; vB[0] = last ? vBn[0] : vBc[0]; vB[1] = last ? vBn[1] : vBc[1];
            if constexpr (SP2) {
            PG8_LDB(B0, 0, 0); PG8_LDB(B1, 0, 1); PG8_SCHED; PG8_LDA(At, 0, 0); PG8_STAGE(PG8_SA(1, 1), a1 + hstep, voffA);
            PG8_WAIT_V(8); PG8_WAIT_L(0); PG8_BAR; PG8_MMA(0, 0, At, B0); PG8_MMA(0, 1, At, B1); PG8_BAR; PG8_SCHED;
            PG8_LDA(At, 0, 1); PG8_STAGE(PG8_SB(0, 0), b2, vB); PG8_STAGE(PG8_SB(0, 1), b2 + hstep, vB); PG8_STAGE(PG8_SA(0, 0), a2, voffA);
            PG8_WAIT_V(8); PG8_WAIT_L(0); PG8_BAR; PG8_MMA(1, 0, At, B0); PG8_MMA(1, 1, At, B1); PG8_BAR; PG8_SCHED;
            PG8_LDB(B0, 1, 0); PG8_LDB(B1, 1, 1); PG8_SCHED; PG8_LDA(At, 1, 0); PG8_STAGE(PG8_SA(0, 1), a2 + hstep, voffA);
            PG8_WAIT_V(8); PG8_WAIT_L(0); PG8_BAR; PG8_MMA(0, 0, At, B0); PG8_MMA(0, 1, At, B1); PG8_BAR; PG8_SCHED;
            PG8_LDA(At, 1, 1); PG8_STAGE(PG8_SB(1, 0), b3, vB); PG8_STAGE(PG8_SB(1, 1), b3 + hstep, vB); PG8_STAGE(PG8_SA(1, 0), a3, voffA);
            PG8_WAIT_V(8); PG8_WAIT_L(0); PG8_BAR; PG8_MMA(1, 0, At, B0); PG8_MMA(1, 1, At, B1); PG8_BAR; PG8_SCHED;
            } else {
            PG8_LDB(B0, 0, 0); PG8_SCHED; PG8_LDA(At, 0, 0); PG8_STAGE(PG8_SA(1, 1), a1 + hstep, voffA);
            PG8_WAIT_L(8); PG8_BAR; PG8_WAIT_L(0); PG8_MMA(0, 0, At, B0); PG8_BAR; PG8_SCHED;
            PG8_LDB(B1, 0, 1); PG8_STAGE(PG8_SB(0, 0), b2, vB);
            PG8_BAR; PG8_WAIT_L(0); PG8_MMA(0, 1, At, B1); PG8_BAR;
            PG8_LDA(At, 0, 1); PG8_STAGE(PG8_SA(0, 0), a2, voffA);
            PG8_BAR; PG8_WAIT_L(0); PG8_MMA(1, 0, At, B0); PG8_BAR; PG8_SCHED;
            PG8_STAGE(PG8_SB(0, 1), b2 + hstep, vB);
            PG8_WAIT_V(6); PG8_BAR; PG8_MMA(1, 1, At, B1); PG8_BAR;
            PG8_LDB(B0, 1, 0); PG8_SCHED; PG8_LDA(At, 1, 0); PG8_STAGE(PG8_SA(0, 1), a2 + hstep, voffA);
            PG8_WAIT_L(8); PG8_BAR; PG8_WAIT_L(0); PG8_MMA(0, 0, At, B0); PG8_BAR; PG8_SCHED;
            PG8_LDB(B1, 1, 1); PG8_STAGE(PG8_SB(1, 0), b3, vB);
            PG8_BAR; PG8_WAIT_L(0); PG8_MMA(0, 1, At, B1); PG8_BAR;
            PG8_LDA(At, 1, 1); PG8_STAGE(PG8_SA(1, 0), a3, voffA);
            PG8_BAR; PG8_WAIT_L(0); PG8_MMA(1, 0, At, B0); PG8_BAR; PG8_SCHED;
            PG8_STAGE(PG8_SB(1, 1), b3 + hstep, vB);
            PG8_WAIT_V(6); PG8_BAR; PG8_MMA(1, 1, At, B1); PG8_BAR;
            }
        }
        if constexpr (ALIGN_EPI) { if (wr == 0) PG8_BAR; }
        E(acc, cur, wr, wc, fr, fq);
        if (!has_next) break;
#pragma unroll
        for (int a = 0; a < 2; ++a)
#pragma unroll
            for (int b = 0; b < 2; ++b)
#pragma unroll
                for (int m = 0; m < 4; ++m)
#pragma unroll
                    for (int n = 0; n < 2; ++n) acc[a][b][m][n] = (f32x4){0.f, 0.f, 0.f, 0.f};
        cur = nxt; cA = nA; cB = nB; ++ui; vBc[0] = vBn[0]; vBc[1] = vBn[1];
        if constexpr (ALIGN_EPI) { if (wr == 1) PG8_BAR; }
    }
    PG8_WAIT_V(0);
    if constexpr (!ALIGN_EPI) { if (wr == 0) PG8_BAR; }
    PG8_BAR;
#undef PG8_SA
#undef PG8_SB
#undef PG8_STAGE
#undef PG8_LDA
#undef PG8_LDB
#undef PG8_MMA
#undef PG8_WAIT_V
#undef PG8_WAIT_L
#undef PG8_BAR
#undef PG8_SCHED
}
}

using pg8::Unit;
typedef f32x4 AccT[2][2][4][2];

struct EpiProj {
    bf16_t *XA, *GA, *Q, *K, *V, *G, *SA, *SB; const float* COS; const float* SIN;
    __device__ __forceinline__ int bkind(const Unit& u) const { const int grp = u.pn >> 2; return (grp == 2 || grp == 3) ? 1 : 0; }
    __device__ __forceinline__ void operator()(const AccT& acc, const Unit& u, int wr, int wc, int fr, int fq) const {
        const int grp = u.pn >> 2;
        if (u.pm == 36 && !(grp == 0 || grp == 2 || grp == 3 || grp == 4)) return;
        const int row0 = u.pm * 256 + wr * 64 + fr;
        if (grp == 2 || grp == 3) {
            bf16_t* dst = (grp == 2) ? Q : K;
            const int c0 = 16 * wc + 4 * fq;
#pragma unroll
            for (int ai = 0; ai < 2; ++ai)
#pragma unroll
                for (int m = 0; m < 4; ++m) {
                    const int r = row0 + ai * 128 + m * 16;
                    if (r >= M1) continue;
                    int trow, nin;
                    if (r < MP) { trow = (r & 2047) + 16; nin = (r & 127) + 1; }
                    else if (r < M) { trow = 2064 + ((r - MP) & 7); nin = ((r - MP) & 7) + 1; }
                    else { trow = r - M; nin = r - M + 1; }
                    const f32x4 cs = *(const f32x4*)(COS + trow * 64 + c0), sn = *(const f32x4*)(SIN + trow * 64 + c0);
#pragma unroll
                    for (int bj = 0; bj < 2; ++bj) {
                        const int head = (u.pn & 3) * 2 + bj;
                        const float e = (float)nin * lg2gamma(head);
                        const float sc = (grp == 2) ? __builtin_amdgcn_exp2f(e) : 0.08838834764831845f * __builtin_amdgcn_exp2f(-e);
                        const f32x4 x1 = acc[ai][bj][m][0], x2 = acc[ai][bj][m][1];
                        const f32x4 o1 = (x1 * cs - x2 * sn) * sc, o2 = (x2 * cs + x1 * sn) * sc;
                        bf16_t* p = dst + (size_t)r * 1024 + head * 128 + c0;
                        u32x2 w1, w2; w1.x = cvt_pk_bf16(o1[0], o1[1]); w1.y = cvt_pk_bf16(o1[2], o1[3]); w2.x = cvt_pk_bf16(o2[0], o2[1]); w2.y = cvt_pk_bf16(o2[2], o2[3]);
                        *(u32x2*)p = w1; *(u32x2*)(p + 64) = w2;
                    }
                }
            return;
        }
        bf16_t* dst; int pitch, colt;
        if (grp == 0) { dst = XA; pitch = 1024; colt = (u.pn & 3) * 256; }
        else if (grp == 1) { dst = GA; pitch = 1024; colt = (u.pn & 3) * 256; }
        else if (grp == 4) { dst = V; pitch = 1024; colt = (u.pn & 3) * 256; }
        else if (grp == 5) { dst = G; pitch = 1024; colt = (u.pn & 3) * 256; }
        else if (grp < 8) { dst = SA; pitch = 2048; colt = (u.pn - 24) * 256; }
        else { dst = SB; pitch = 2048; colt = (u.pn - 32) * 256; }
        const int act = (grp == 1) ? 1 : (grp == 5) ? 2 : (grp >= 6) ? 3 : 0;
        const int col0 = colt + wc * 32 + 8 * fq;
#pragma unroll
        for (int ai = 0; ai < 2; ++ai)
#pragma unroll
            for (int m = 0; m < 4; ++m) {
                const int r = row0 + ai * 128 + m * 16;
                bf16_t* rowp = dst + (size_t)r * pitch + col0;
#pragma unroll
                for (int bj = 0; bj < 2; ++bj) {
                    f32x4 v0 = acc[ai][bj][m][0], v1 = acc[ai][bj][m][1];
                    if (act == 1) {
#pragma unroll
                        for (int j = 0; j < 4; ++j) { v0[j] = gelu_tanh(v0[j]); v1[j] = gelu_tanh(v1[j]); } }
                    else if (act == 2) {
#pragma unroll
                        for (int j = 0; j < 4; ++j) { v0[j] = silu_f(v0[j]); v1[j] = silu_f(v1[j]); } }
                    else if (act == 3) {
#pragma unroll
                        for (int j = 0; j < 4; ++j) { v0[j] = fast_sigmoid(v0[j]); v1[j] = fast_sigmoid(v1[j]); } }
                    u32x4 w; w.x = cvt_pk_bf16(v0[0], v0[1]); w.y = cvt_pk_bf16(v0[2], v0[3]); w.z = cvt_pk_bf16(v1[0], v1[1]); w.w = cvt_pk_bf16(v1[2], v1[3]);
                    *(u32x4*)(rowp + bj * 128) = w;
                }
            }
    }
};

struct WUnit { int kind, pm, pn, kt0, nkt; };
constexpr bool P6_BALANCED = false;
constexpr int NSLOT3 = 288, NSLOT4 = 288, NSLOT5 = 1152, NSLOTS = NSLOT3 + NSLOT4 + NSLOT5;
__device__ __forceinline__ void tile_of(int l, int nN, int& pm, int& pn) {
    const int round = l >> 8, pos = l & 255, x = pos >> 5, wi = pos & 31;
    if (nN == 8) {
        if (round == 0) { pm = 8 * (x >> 1) + (wi & 7); pn = 4 * (x & 1) + (wi >> 3); }
        else { pm = 32 + (pos & 3); pn = pos >> 2; }
    } else {
        if (round < 4) { pm = 8 * round + (wi & 7); pn = 4 * x + (wi >> 3); }
        else { pm = 32 + (wi & 3); pn = 8 * x + (wi >> 2); }
    }
}
__device__ __forceinline__ bool sched_next(int c, int s, WUnit& u) {
    const int n3 = (c < 32) ? 2 : 1;
    int j, sub = 0;
    if (s < 2 * n3) { j = s >> 1; sub = s & 1; } else j = s - n3;
    const int L = c + 256 * j;
    if (L < NSLOT3) { u.kind = sub; tile_of(L, 8, u.pm, u.pn); u.kt0 = 0; u.nkt = 16; return true; }
    if (L < NSLOT3 + NSLOT4) { u.kind = 2; tile_of(L - NSLOT3, 8, u.pm, u.pn); u.kt0 = 0; u.nkt = 32; return true; }
    if (L < NSLOTS) { u.kind = 3; tile_of(L - NSLOT3 - NSLOT4, 32, u.pm, u.pn); u.kt0 = 0; u.nkt = 32; return true; }
    const int nsl = (c < 192) ? 7 : 6;
    const int q = j - nsl;
    const int x = c >> 5, wi = c & 31;
    int r0, r1;
    if (P6_BALANCED) { const int xp = (x >= 6) ? x - 6 : x + 2; r0 = (xp < 2) ? 168 * xp : 336 + 136 * (xp - 2); r1 = r0 + ((xp < 2) ? 168 : 136); }
    else { r0 = 144 * x; r1 = r0 + 144; }
    int pos = r0;
    for (int i = 0; i < 3; ++i) {
        if (pos >= r1) return false;
        const int blk = pos >> 7, k0 = pos & 127, len = min(128 - k0, r1 - pos);
        if (i == q) { u.kind = k0 ? 5 : 4; u.kt0 = k0; u.nkt = len;
            if (blk < 8) { u.pm = 8 * (blk >> 1) + (wi & 7); u.pn = 4 * (blk & 1) + (wi >> 3); } else { u.pm = 32 + (wi & 3); u.pn = wi >> 2; }
            return true; }
        pos += len;
    }
    return false;
}
struct StreamEpi {
    const bf16_t* SA; bf16_t* SBM;
    const float* xp; const float* xs; float* X; bf16_t* X1N; const float* gf; float* ss1;
    bf16_t* U;
    float* SLAB;
    __device__ __forceinline__ int bkind(const WUnit& u) const { return (u.kind == 2 || u.kind >= 4) ? 2 : 0; }
    __device__ __forceinline__ void operator()(AccT& acc, const WUnit& u, int wr, int wc, int fr, int fq) const {
        const int row0 = u.pm * 256 + wr * 64 + fr;
        if (u.kind <= 1) {
            const int col0 = u.pn * 256 + wc * 32 + 8 * fq;
#pragma unroll
            for (int ai = 0; ai < 2; ++ai)
#pragma unroll
                for (int m = 0; m < 4; ++m) { const size_t off = (size_t)(row0 + ai * 128 + m * 16) * DM + col0;
#pragma unroll
                    for (int bj = 0; bj < 2; ++bj) {
                        const u32x4 sb = *(const u32x4*)(SBM + off + bj * 128);
                        float g[8];
#pragma unroll
                        for (int q = 0; q < 4; ++q) { g[2 * q] = bf2f(sb[q] & 0xffffu); g[2 * q + 1] = bf2f(sb[q] >> 16); }
                        if (u.kind == 0) {
                            const u32x4 sa = *(const u32x4*)(SA + off + bj * 128);
#pragma unroll
                            for (int q = 0; q < 4; ++q) { g[2 * q] = bf2f(sa[q] & 0xffffu) * __builtin_amdgcn_rcpf(fmaxf(g[2 * q], 1e-30f)); g[2 * q + 1] = bf2f(sa[q] >> 16) * __builtin_amdgcn_rcpf(fmaxf(g[2 * q + 1], 1e-30f)); }
#pragma unroll
                            for (int j = 0; j < 4; ++j) { acc[ai][bj][m][0][j] *= g[j]; acc[ai][bj][m][1][j] *= g[4 + j]; }
                        } else {
                            f32x4 v0 = acc[ai][bj][m][0], v1 = acc[ai][bj][m][1];
#pragma unroll
                            for (int j = 0; j < 4; ++j) { v0[j] *= g[j]; v1[j] *= g[4 + j]; }
                            u32x4 w; w.x = cvt_pk_bf16(v0[0], v0[1]); w.y = cvt_pk_bf16(v0[2], v0[3]); w.z = cvt_pk_bf16(v1[0], v1[1]); w.w = cvt_pk_bf16(v1[2], v1[3]);
                            *(u32x4*)(SBM + off + bj * 128) = w;
                        }
                    } }
        } else if (u.kind == 2) {
            const int col0 = u.pn * 256 + wc * 32 + 4 * fq;
            const float* xin = (u.pm < 32) ? xp : (xs - (size_t)MP * DM);
            f32x4 gv[2][2];
#pragma unroll
            for (int bj = 0; bj < 2; ++bj)
#pragma unroll
                for (int n = 0; n < 2; ++n) gv[bj][n] = *(const f32x4*)(gf + col0 + bj * 128 + n * 16);
#pragma unroll
            for (int ai = 0; ai < 2; ++ai)
#pragma unroll
                for (int m = 0; m < 4; ++m) { const int r = row0 + ai * 128 + m * 16; const size_t off = (size_t)r * DM + col0; float s = 0.f;
#pragma unroll
                    for (int bj = 0; bj < 2; ++bj)
#pragma unroll
                        for (int n = 0; n < 2; ++n) { const f32x4 x = *(const f32x4*)(xin + off + bj * 128 + n * 16); const f32x4 o = x + acc[ai][bj][m][n];
                            *(f32x4*)(X + off + bj * 128 + n * 16) = o; s += (o[0] * o[0] + o[1] * o[1]) + (o[2] * o[2] + o[3] * o[3]);
                            const f32x4 h = o * gv[bj][n]; u32x2 w; w.x = cvt_pk_bf16(h[0], h[1]); w.y = cvt_pk_bf16(h[2], h[3]);
                            *(u32x2*)(X1N + off + bj * 128 + n * 16) = w; }
                    s += __shfl_xor(s, 16); s += __shfl_xor(s, 32);
                    if (fq == 0) atomicAdd(ss1 + r, s); }
        } else if (u.kind == 3) {
            const int col0 = u.pn * 256 + wc * 32 + 8 * fq;
#pragma unroll
            for (int ai = 0; ai < 2; ++ai)
#pragma unroll
                for (int m = 0; m < 4; ++m) { const int r = row0 + ai * 128 + m * 16;
                    const float rstd = __builtin_amdgcn_rsqf(__hip_atomic_load(ss1 + r, __ATOMIC_RELAXED, __HIP_MEMORY_SCOPE_AGENT) * (1.0f / DM) + EPS);
                    bf16_t* rowp = U + (size_t)r * DFF + col0;
#pragma unroll
                    for (int bj = 0; bj < 2; ++bj) { f32x4 v0 = acc[ai][bj][m][0] * rstd, v1 = acc[ai][bj][m][1] * rstd;
#pragma unroll
                        for (int j = 0; j < 4; ++j) { const float a = fmaxf(v0[j], 0.f), b = fmaxf(v1[j], 0.f); v0[j] = a * a; v1[j] = b * b; }
                        u32x4 w; w.x = cvt_pk_bf16(v0[0], v0[1]); w.y = cvt_pk_bf16(v0[2], v0[3]); w.z = cvt_pk_bf16(v1[0], v1[1]); w.w = cvt_pk_bf16(v1[2], v1[3]);
                        *(u32x4*)(rowp + bj * 128) = w; } }
        } else {
            const int col0 = u.pn * 256 + wc * 32 + 4 * fq;
            const bool prim = (u.kind == 4), whole = (u.nkt == 128);
#pragma unroll
            for (int ai = 0; ai < 2; ++ai)
#pragma unroll
                for (int m = 0; m < 4; ++m) { const size_t off = (size_t)(row0 + ai * 128 + m * 16) * DM + col0;
#pragma unroll
                    for (int bj = 0; bj < 2; ++bj)
#pragma unroll
                        for (int n = 0; n < 2; ++n) {
                            if (prim) { const f32x4 x = *(const f32x4*)(X + off + bj * 128 + n * 16); *(f32x4*)(X + off + bj * 128 + n * 16) = x + acc[ai][bj][m][n];
                                if (whole) *(f32x4*)(SLAB + off + bj * 128 + n * 16) = (f32x4){0.f, 0.f, 0.f, 0.f}; }
                            else *(f32x4*)(SLAB + off + bj * 128 + n * 16) = acc[ai][bj][m][n]; } }
        }
    }
};
struct StreamPtrs { const bf16_t *YAB, *PA, *PB, *MG, *WOUT, *X1N, *WUP, *U, *WDN; };
namespace pg8 {
__device__ __forceinline__ void gemm_stream(LAS unsigned char* lds, const StreamPtrs& T, const StreamEpi& E, const int c, const int kmin, const int kmax) {
    const int tid = threadIdx.x, wid = __builtin_amdgcn_readfirstlane(tid >> 6), lane = tid & 63, wr = wid >> 2, wc = wid & 3, fr = lane & 15, fq = lane >> 4;
    int sR[2], sC[2];
#pragma unroll
    for (int i = 0; i < 2; ++i) stage_rc(tid * 16 + i * 8192, sR[i], sC[i]);
    const size_t kstep = (size_t)(BK * 2);
    const unsigned ldsw = (unsigned)wid * 1024u;
    const int aoff = lds_byte(wr * 64 + fr, fq * 8), boff = lds_byte(wc * 32 + fr, fq * 8);
#define PG8_SA(b, h) (((b) * 2 + (h)) * HTB)
#define PG8_SB(b, h) ((4 + (b) * 2 + (h)) * HTB)
#define PG8_STAGE(bufoff, gbase, voff) do { _Pragma("unroll") for (int _i = 0; _i < 2; ++_i) \
        __builtin_amdgcn_global_load_lds((const unsigned*)((const char*)(gbase) + (voff)[_i]), (LAS unsigned*)(lds + (bufoff) + ldsw + _i * 8192), 16, 0, 0); } while (0)
#define PG8_LDA(dst, b, h) do { _Pragma("unroll") for (int m = 0; m < 4; ++m) _Pragma("unroll") for (int k = 0; k < 2; ++k) dst[m][k] = *(const LAS bf16x8*)(lds + PG8_SA(b, h) + aoff + m * 2048 + k * 1024); } while (0)
#define PG8_LDB(dst, b, h) do { _Pragma("unroll") for (int n = 0; n < 2; ++n) _Pragma("unroll") for (int k = 0; k < 2; ++k) dst[n][k] = *(const LAS bf16x8*)(lds + PG8_SB(b, h) + boff + n * 2048 + k * 1024); } while (0)
#define PG8_MMA(ai, bj, At, Bt) do { __builtin_amdgcn_s_setprio(1); _Pragma("unroll") for (int m = 0; m < 4; ++m) _Pragma("unroll") for (int n = 0; n < 2; ++n) _Pragma("unroll") for (int k = 0; k < 2; ++k) \
        acc[ai][bj][m][n] = __builtin_amdgcn_mfma_f32_16x16x32_bf16(Bt[n][k], At[m][k], acc[ai][bj][m][n], 0, 0, 0); __builtin_amdgcn_s_setprio(0); } while (0)
#define PG8_WAIT_V(n) asm volatile("s_waitcnt vmcnt(" #n ")" ::: "memory")
#define PG8_WAIT_L(n) asm volatile("s_waitcnt lgkmcnt(" #n ")" ::: "memory")
#define PG8_BAR __builtin_amdgcn_s_barrier()
#define PG8_SCHED __builtin_amdgcn_sched_barrier(0)
#define PG8_SETUP(u, pA, pB, hs, vA, vB) do { const bf16_t* _a; const bf16_t* _b; int _p; \
        if ((u).kind == 0) { _a = T.YAB; _b = T.PA; _p = DM; } else if ((u).kind == 1) { _a = T.YAB + LW; _b = T.PB; _p = DM; } \
        else if ((u).kind == 2) { _a = T.MG; _b = T.WOUT; _p = DM; } else if ((u).kind == 3) { _a = T.X1N; _b = T.WUP; _p = DM; } else { _a = T.U; _b = T.WDN; _p = DFF; } \
        const int _pb = ((u).kind <= 1) ? LW : _p;        \
        pA = (const char*)(_a + (size_t)(u).pm * 256 * _p + (u).kt0 * BK); pB = (const char*)(_b + (size_t)(u).pn * 256 * _pb + (u).kt0 * BK); \
        hs[0] = (size_t)HALF * _p * 2; hs[1] = (size_t)HALF * _pb * 2; const int _kd = E.bkind(u); \
        _Pragma("unroll") for (int _i = 0; _i < 2; ++_i) { vA[_i] = (unsigned)(sR[_i] * _p + sC[_i]) * 2u; vB[_i] = (unsigned)(brow_perm(sR[_i], _kd) * _pb + sC[_i]) * 2u; } } while (0)
    WUnit cur, nxt; int s = 0;
    for (;;) { if (!sched_next(c, s, cur)) return; if (cur.kind >= kmin) break; ++s; }
    if (cur.kind > kmax) return;
    const char *cA, *cB, *nA, *nB; size_t hsC[2], hsN[2]; unsigned vAc[2], vBc[2], vAn[2], vBn[2];
    PG8_SETUP(cur, cA, cB, hsC, vAc, vBc);
    f32x4 acc[2][2][4][2];
#pragma unroll
    for (int a = 0; a < 2; ++a)
#pragma unroll
        for (int b = 0; b < 2; ++b)
#pragma unroll
            for (int m = 0; m < 4; ++m)
#pragma unroll
                for (int n = 0; n < 2; ++n) acc[a][b][m][n] = (f32x4){0.f, 0.f, 0.f, 0.f};
    bf16x8 At[4][2], B0[2][2], B1[2][2];
    PG8_STAGE(PG8_SB(0, 0), cB, vBc); PG8_STAGE(PG8_SB(0, 1), cB + hsC[1], vBc); PG8_STAGE(PG8_SA(0, 0), cA, vAc); PG8_STAGE(PG8_SA(0, 1), cA + hsC[0], vAc);
    if (wr == 1) PG8_BAR;
    PG8_WAIT_V(2); PG8_BAR;
    PG8_STAGE(PG8_SB(1, 0), cB + kstep, vBc); PG8_STAGE(PG8_SA(1, 0), cA + kstep, vAc); PG8_STAGE(PG8_SB(1, 1), cB + hsC[1] + kstep, vBc);
    PG8_WAIT_V(6); PG8_BAR;
    for (;;) {
        bool has_next = sched_next(c, s + 1, nxt); if (has_next && nxt.kind > kmax) has_next = false;
        if (has_next) { PG8_SETUP(nxt, nA, nB, hsN, vAn, vBn); }
        else { nA = cA; nB = cB; hsN[0] = hsC[0]; hsN[1] = hsC[1]; vAn[0] = vAc[0]; vAn[1] = vAc[1]; vBn[0] = vBc[0]; vBn[1] = vBc[1]; }
        const int nt = cur.nkt;
        for (int t = 0; t < nt; t += 2) {
            const bool last = (t == nt - 2);
            const char* a1 = cA + (size_t)(t + 1) * kstep;
            const char* a2 = last ? nA : cA + (size_t)(t + 2) * kstep; const char* b2 = last ? nB : cB + (size_t)(t + 2) * kstep;
            const char* a3 = a2 + kstep; const char* b3 = b2 + kstep;
            const size_t hA2 = last ? hsN[0] : hsC[0], hB2 = last ? hsN[1] : hsC[1];
            unsigned vA2[2], vB2[2]; vA2[0] = last ? vAn[0] : vAc[0]; vA2[1] = last ? vAn[1] : vAc[1]; vB2[0] = last ? vBn[0] : vBc[0]; vB2[1] = last ? vBn[1] : vBc[1];
            PG8_LDB(B0, 0, 0); PG8_LDB(B1, 0, 1); PG8_SCHED; PG8_LDA(At, 0, 0); PG8_STAGE(PG8_SA(1, 1), a1 + hsC[0], vAc);
            PG8_WAIT_V(8); PG8_WAIT_L(0); PG8_BAR; PG8_MMA(0, 0, At, B0); PG8_MMA(0, 1, At, B1); PG8_BAR; PG8_SCHED;
            PG8_LDA(At, 0, 1); PG8_STAGE(PG8_SB(0, 0), b2, vB2); PG8_STAGE(PG8_SB(0, 1), b2 + hB2, vB2); PG8_STAGE(PG8_SA(0, 0), a2, vA2);
            PG8_WAIT_V(8); PG8_WAIT_L(0); PG8_BAR; PG8_MMA(1, 0, At, B0); PG8_MMA(1, 1, At, B1); PG8_BAR; PG8_SCHED;
            PG8_LDB(B0, 1, 0); PG8_LDB(B1, 1, 1); PG8_SCHED; PG8_LDA(At, 1, 0); PG8_STAGE(PG8_SA(0, 1), a2 + hA2, vA2);
            PG8_WAIT_V(8); PG8_WAIT_L(0); PG8_BAR; PG8_MMA(0, 0, At, B0); PG8_MMA(0, 1, At, B1); PG8_BAR; PG8_SCHED;
            PG8_LDA(At, 1, 1); PG8_STAGE(PG8_SB(1, 0), b3, vB2); PG8_STAGE(PG8_SB(1, 1), b3 + hB2, vB2); PG8_STAGE(PG8_SA(1, 0), a3, vA2);
            PG8_WAIT_V(8); PG8_WAIT_L(0); PG8_BAR; PG8_MMA(1, 0, At, B0); PG8_MMA(1, 1, At, B1); PG8_BAR; PG8_SCHED;
        }
        if (wr == 0) PG8_BAR;
        E(acc, cur, wr, wc, fr, fq);
        if (!has_next) break;
        if (nxt.kind != 1) {
#pragma unroll
            for (int a = 0; a < 2; ++a)
#pragma unroll
                for (int b = 0; b < 2; ++b)
#pragma unroll
                    for (int m = 0; m < 4; ++m)
#pragma unroll
                        for (int n = 0; n < 2; ++n) acc[a][b][m][n] = (f32x4){0.f, 0.f, 0.f, 0.f};
        }
        cur = nxt; cA = nA; cB = nB; ++s; hsC[0] = hsN[0]; hsC[1] = hsN[1]; vAc[0] = vAn[0]; vAc[1] = vAn[1]; vBc[0] = vBn[0]; vBc[1] = vBn[1];
        if (wr == 1) PG8_BAR;
    }
    PG8_WAIT_V(0);
    PG8_BAR;
#undef PG8_SETUP
#undef PG8_SA
#undef PG8_SB
#undef PG8_STAGE
#undef PG8_LDA
#undef PG8_LDB
#undef PG8_MMA
#undef PG8_WAIT_V
#undef PG8_WAIT_L
#undef PG8_BAR
#undef PG8_SCHED
}
}
#define XB_TMO      128
#define XB_XCNT(j)  (256  + 64 * (j))
#define XB_XSUB(j)  (1280 + 64 * (j))
#define XB_XGEN(j)  (2304 + 64 * (j))
#define XB_TOP      3328
#define XB_TOPGEN   3392
#define XCD_BAR_WORDS 3456
#define XB_SPIN_CAP (1u << 18)
__device__ __forceinline__ unsigned xb_ld(unsigned* p)              { return __hip_atomic_load(p, __ATOMIC_RELAXED, __HIP_MEMORY_SCOPE_AGENT); }
__device__ __forceinline__ unsigned xb_add(unsigned* p, unsigned v) { return __hip_atomic_fetch_add(p, v, __ATOMIC_RELAXED, __HIP_MEMORY_SCOPE_AGENT); }
__device__ __forceinline__ unsigned xb_xcc_id() { return (unsigned)__builtin_amdgcn_s_getreg((3 << 11) | 20) & 0xFu; }
#define XB_SPIN(cond, bar) do { unsigned _sp = 0; while (cond) { __builtin_amdgcn_s_sleep(1); \
    if ((++_sp & 255u) == 0u) { if (xb_ld(&(bar)[XB_TMO])) break; if (_sp > XB_SPIN_CAP) { atomicAdd(&(bar)[XB_TMO], 1u); break; } } } } while (0)
struct XcdBarrier { unsigned* bar; unsigned x; volatile LAS unsigned* st; };
__device__ __forceinline__ XcdBarrier xcd_barrier_post(unsigned* bar, volatile LAS unsigned* st) {
    XcdBarrier b; b.bar = bar; b.x = xb_xcc_id(); b.st = st;
    if (threadIdx.x == 0) (void)xb_add(&bar[XB_XCNT(b.x)], 1u);
    return b;
}
__device__ __forceinline__ void xcd_barrier_complete(unsigned* bar, unsigned x, unsigned& nloc, unsigned& nx) {
    const unsigned G = gridDim.x * gridDim.y * gridDim.z;
    unsigned sum, cnt, mine, sp = 0u;
    for (;;) {
        sum = 0u; cnt = 0u; mine = 0u;
#pragma unroll
        for (unsigned j = 0; j < 16; ++j) { const unsigned c = xb_ld(&bar[XB_XCNT(j)]); sum += c; cnt += (c > 0u) ? 1u : 0u; mine = (j == x) ? c : mine; }
        if (sum == G) break;
        __builtin_amdgcn_s_sleep(1);
        if ((++sp & 255u) == 0u) { if (xb_ld(&bar[XB_TMO])) break; if (sp > XB_SPIN_CAP) { atomicAdd(&bar[XB_TMO], 1u); break; } }
    }
    nloc = mine > 0u ? mine : 1u; nx = cnt > 0u ? cnt : 1u;
}
__device__ __forceinline__ void xcd_barrier(const XcdBarrier& b) {
    asm volatile("s_waitcnt vmcnt(0)" ::: "memory");
    __syncthreads();
    if (threadIdx.x == 0) {
        unsigned* bar = b.bar;
        __builtin_amdgcn_s_waitcnt(0);
        unsigned nloc = b.st[0], nx = b.st[1];
        if (nloc == 0u) { xcd_barrier_complete(bar, b.x, nloc, nx); b.st[0] = nloc; b.st[1] = nx; }
        const unsigned old = xb_add(&bar[XB_XSUB(b.x)], 1u);
        const unsigned gen = old / nloc;
        if (old + 1u == (gen + 1u) * nloc) {
            __builtin_amdgcn_fence(__ATOMIC_RELEASE, "agent");
            asm volatile("s_waitcnt vmcnt(0)" ::: "memory");
            const unsigned og = xb_add(&bar[XB_TOP], 1u);
            const unsigned tg = og / nx;
            if (og + 1u == (tg + 1u) * nx) xb_add(&bar[XB_TOPGEN], 1u);
            else XB_SPIN(xb_ld(&bar[XB_TOPGEN]) == tg, bar);
            __builtin_amdgcn_fence(__ATOMIC_ACQUIRE, "agent");
            xb_add(&bar[XB_XGEN(b.x)], 1u);
            asm volatile("s_waitcnt vmcnt(0)" ::: "memory");
        } else {
            XB_SPIN(xb_ld(&bar[XB_XGEN(b.x)]) == gen, bar);
            __builtin_amdgcn_fence(__ATOMIC_ACQUIRE, "agent");
            asm volatile("s_waitcnt vmcnt(0)" ::: "memory");
        }
    }
    __syncthreads();
}

constexpr int RING_BYTES = 131072;
constexpr int LDSCTL_OFF = RING_BYTES, MISC_OFF = LDSCTL_OFF + 320;
constexpr int LDS_BYTES = 147456;
constexpr int NWAVES = 8, NTHR = 512;

struct Params { const float* in[23]; float* out; unsigned char* ws; int ph_lo, ph_hi, li, pad; };
struct Ctx { LAS unsigned char* lds; int tid, lane, wave, vcu, G; };

__device__ __forceinline__ void p0_transpose_item(const float* W, int K, int N, bf16_t* WT, LAS float* scr, int item, int lane) {
    const int nblk = N / 32, kb = item / nblk, nb = item % nblk, k0 = 64 * kb, n0 = 32 * nb;
    float wv[32];
#pragma unroll
    for (int i = 0; i < 32; ++i) { const int kk = 2 * i + (lane >> 5); wv[i] = __builtin_nontemporal_load(W + (size_t)(k0 + kk) * N + n0 + (lane & 31)); }
#pragma unroll
    for (int i = 0; i < 32; ++i) { const int kk = 2 * i + (lane >> 5); scr[kk * 33 + (lane & 31)] = wv[i]; }
    LDS_WAIT(); asm volatile("" ::: "memory");
    const int c = lane & 7;
#pragma unroll
    for (int j = 0; j < 4; ++j) { const int n = (lane >> 3) + 8 * j; const LAS float* s = scr + (8 * c) * 33 + n;
        u32x4 o; o.x = pk2(s[0 * 33], s[1 * 33]); o.y = pk2(s[2 * 33], s[3 * 33]); o.z = pk2(s[4 * 33], s[5 * 33]); o.w = pk2(s[6 * 33], s[7 * 33]);
        *(u32x4*)(WT + (size_t)(n0 + n) * K + k0 + 8 * c) = o; }
    LDS_WAIT(); asm volatile("" ::: "memory");
}
__device__ __forceinline__ void rms_row_to_bf16(const float* xrow, const float* g, bf16_t* orow, int lane) {
    const f32x4* xr = (const f32x4*)xrow + lane; const f32x4* gr = (const f32x4*)g + lane;
    f32x4 v[8]; float s = 0.f;
#pragma unroll
    for (int j = 0; j < 8; ++j) { v[j] = xr[64 * j]; s += (v[j][0] * v[j][0] + v[j][1] * v[j][1]) + (v[j][2] * v[j][2] + v[j][3] * v[j][3]); }
    const float rstd = 1.0f / sqrtf(wave_sum(s) * (1.f / DM) + EPS);
    u32x2* o8 = (u32x2*)orow + lane;
#pragma unroll
    for (int j = 0; j < 8; ++j) { const f32x4 gg = gr[64 * j]; u32x2 w; w.x = pk2(v[j][0] * rstd * gg[0], v[j][1] * rstd * gg[1]); w.y = pk2(v[j][2] * rstd * gg[2], v[j][3] * rstd * gg[3]); o8[64 * j] = w; }
}
__device__ __forceinline__ void sincos_entry(int idx, float* COS, float* SIN) {
    const int tr = idx >> 6, i = idx & 63;
    const double pos = (tr < 2064) ? (double)tr : (double)(16384 + (tr - 2064));
    const double ang = pos * INVF[i];
    const double k = __builtin_rint(ang * 0.63661977236758134308);
    double y = __builtin_fma(-k, 1.57079632679489655800e+00, ang);
    y = __builtin_fma(-k, 6.12323399573676603587e-17, y);
    const double z = y * y;
    double sp = -7.6471637318198164759e-13;
    sp = sp * z + 1.6059043836821614599e-10;
    sp = sp * z - 2.5052108385441718775e-08;
    sp = sp * z + 2.7557319223985890653e-06;
    sp = sp * z - 1.9841269841269841270e-04;
    sp = sp * z + 8.3333333333333333333e-03;
    sp = sp * z - 1.6666666666666666667e-01;
    const double s = y + y * z * sp;
    double cp = 4.7794773323873852974e-14;
    cp = cp * z - 1.1470745597729724714e-11;
    cp = cp * z + 2.0876756987868098979e-09;
    cp = cp * z - 2.7557319223985890653e-07;
    cp = cp * z + 2.4801587301587301587e-05;
    cp = cp * z - 1.3888888888888888889e-03;
    cp = cp * z + 4.1666666666666666667e-02;
    cp = cp * z - 0.5;
    const double c = 1.0 + z * cp;
    const int q = ((int)(long long)k) & 3;
    const double sv = (q == 0) ? s : (q == 1) ? c : (q == 2) ? -s : -c;
    const double cv = (q == 0) ? c : (q == 1) ? -s : (q == 2) ? -c : s;
    COS[idx] = (float)cv; SIN[idx] = (float)sv;
}
__device__ __forceinline__ void p0_prep(const Ctx& C, const Params& P) {
    unsigned char* ws = P.ws;
    LAS float* scr = (LAS float*)(C.lds + C.wave * 16384);
    const int gw = C.vcu * NWAVES + C.wave, NGW = C.G * NWAVES;
    constexpr int I_IN = (DM / 64) * (DPROJ / 32), I_UP = (DM / 64) * (DFF / 32), I_DN = (DFF / 64) * (DM / 32), I_OUT = (DM / 64) * (DM / 32), I_PA = (LW / 64) * (DM / 32);
    constexpr int NITEMS = I_IN + I_UP + I_DN + I_OUT + 2 * I_PA;
    for (int it = gw; it < NITEMS; it += NGW) {
        int r = it;
        if (r < I_IN) { p0_transpose_item(P.in[7], DM, DPROJ, (bf16_t*)(ws + WS_WIN), scr, r, C.lane); continue; } r -= I_IN;
        if (r < I_UP) { p0_transpose_item(P.in[20], DM, DFF, (bf16_t*)(ws + WS_WUP), scr, r, C.lane); continue; } r -= I_UP;
        if (r < I_DN) { p0_transpose_item(P.in[21], DFF, DM, (bf16_t*)(ws + WS_WDN), scr, r, C.lane); continue; } r -= I_DN;
        if (r < I_OUT) { p0_transpose_item(P.in[18], DM, DM, (bf16_t*)(ws + WS_WOUT), scr, r, C.lane); continue; } r -= I_OUT;
        if (r < I_PA) { p0_transpose_item(P.in[16], LW, DM, (bf16_t*)(ws + WS_PA), scr, r, C.lane); continue; } r -= I_PA;
        p0_transpose_item(P.in[17], LW, DM, (bf16_t*)(ws + WS_PB), scr, r, C.lane);
    }
    bf16_t* H = (bf16_t*)(ws + WS_H);
    for (int m = gw; m < M1PAD; m += NGW) {
        bf16_t* orow = H + (size_t)m * DM;
        if (m < M1) {
            const float* xrow = (m < MP) ? P.in[0] + (size_t)m * DM : (m < M) ? P.in[1] + (size_t)(m - MP) * DM : P.in[5] + (size_t)(m - M) * DM;
            rms_row_to_bf16(xrow, P.in[6], orow, C.lane);
        } else {
            u32x2* o8 = (u32x2*)orow + C.lane;
#pragma unroll
            for (int j = 0; j < 8; ++j) o8[64 * j] = (u32x2){0u, 0u};
        }
    }
    float* COS = (float*)(ws + WS_TAB); float* SIN = COS + TABROWS * 64;
    const int gt = C.vcu * NTHR + C.tid, NGT = C.G * NTHR;
    for (int i = gt; i < TABROWS * 64; i += NGT) sincos_entry(i, COS, SIN);
    float* ss = (float*)(ws + WS_SS);
    for (int i = gt; i < 2 * M; i += NGT) ss[i] = 0.f;
    bf16_t* waT = (bf16_t*)(ws + WS_LRUW); bf16_t* wxT = waT + NBLK * 4096;
    for (int i = gt; i < 2 * NBLK * 4096; i += NGT) {
        const int g = i >> 16, r = i & 65535, n = r >> 12, d = (r >> 6) & 63, c = r & 63;
        const float* src = g ? P.in[12] : P.in[10];
        (g ? wxT : waT)[r] = (bf16_t)f2bf(src[(n * 64 + c) * 64 + d]);
    }
}

typedef short v4i16_t __attribute__((ext_vector_type(4)));
constexpr int XCB_STRIDE = 144;
constexpr int XCF_STRIDE = 68;
constexpr int LRU_XCB = 0, LRU_XCF = 128 * XCB_STRIDE, LRU_WT = LRU_XCF + 128 * XCF_STRIDE * 4, LRU_HIN = LRU_WT + 8 * 64 * 2 * 4, LRU_END = LRU_HIN + 256;
template <int MODE, bool FINAL>
__device__ __forceinline__ void lru_tile(const Ctx& C, const Params& P, const int n, const int idx) {
    unsigned char* ws = P.ws;
    const bf16_t* XA = (const bf16_t*)(ws + WS_XA); const bf16_t* GA = (const bf16_t*)(ws + WS_GA); bf16_t* YA = (bf16_t*)(ws + WS_YAB);
    const bf16_t* waT = (const bf16_t*)(ws + WS_LRUW) + n * 4096; const bf16_t* wxT = waT + NBLK * 4096;
    float* SUMM = (float*)(ws + WS_SUMM); float* SUMMETA = (float*)(ws + WS_SUMMETA);
    LAS unsigned char* lds = C.lds;
    LAS float* XCF = (LAS float*)(lds + LRU_XCF); LAS float* WT = (LAS float*)(lds + LRU_WT); LAS float* HIN = (LAS float*)(lds + LRU_HIN);
    const int tid = C.tid, lane = C.lane, w = C.wave, fr = lane & 15, fq = lane >> 4;
    const int b = idx >> 4, c = idx & 15;
    const int r0 = (MODE == 0) ? b * SEQ + c * 128 : (MODE == 1) ? MP + idx * 128 : MROW_META;
    const int t = tid >> 2, cg = tid & 3, ch0 = n * 64 + cg * 16;
    float xc[16];
    {
        const f32x4* cb = (const f32x4*)(P.in[9] + ch0);
#pragma unroll
        for (int q = 0; q < 4; ++q) { const f32x4 v = cb[q]; xc[4 * q] = v[0]; xc[4 * q + 1] = v[1]; xc[4 * q + 2] = v[2]; xc[4 * q + 3] = v[3]; }
    }
    u32x4 raw3[2];
#pragma unroll
    for (int j = 0; j < 4; ++j) {
        const int tt = t - 3 + j;
        float xv[16];
        bool from_state = false; int srow = r0 + tt; bool zero = false;
        if (MODE == 0) { if (c == 0 && tt < 0) srow = M1 + tt; }
        else if (MODE == 1) { const int ts = (t & 7) - 3 + j; if (ts < 0) from_state = true; }
        else { if (tt < 0) zero = true; }
        if (MODE == 1 && from_state) {
            const int bseq = idx * 16 + (t >> 3), ts = (t & 7) - 3 + j;
            const f32x4* sp = (const f32x4*)(P.in[2] + ((size_t)bseq * 3 + (3 + ts)) * LW + ch0);
#pragma unroll
            for (int q = 0; q < 4; ++q) { const f32x4 v = sp[q]; xv[4 * q] = v[0]; xv[4 * q + 1] = v[1]; xv[4 * q + 2] = v[2]; xv[4 * q + 3] = v[3]; }
        } else {
            const u32x4* xp = (const u32x4*)(XA + (size_t)(zero ? r0 : srow) * LW + ch0);
            u32x4 v0 = xp[0], v1 = xp[1];
            if (zero) { v0 = (u32x4){0u, 0u, 0u, 0u}; v1 = v0; }
            if (j == 3) { raw3[0] = v0; raw3[1] = v1; }
#pragma unroll
            for (int q = 0; q < 4; ++q) { xv[2 * q] = bf2f(v0[q] & 0xffffu); xv[2 * q + 1] = bf2f(v0[q] >> 16); xv[8 + 2 * q] = bf2f(v1[q] & 0xffffu); xv[8 + 2 * q + 1] = bf2f(v1[q] >> 16); }
        }
        const f32x4* cw = (const f32x4*)(P.in[8] + j * LW + ch0);
#pragma unroll
        for (int q = 0; q < 4; ++q) { const f32x4 wv = cw[q]; xc[4 * q] += wv[0] * xv[4 * q]; xc[4 * q + 1] += wv[1] * xv[4 * q + 1]; xc[4 * q + 2] += wv[2] * xv[4 * q + 2]; xc[4 * q + 3] += wv[3] * xv[4 * q + 3]; }
    }
    u32x4 gav[2];
    if (FINAL) { const u32x4* gp = (const u32x4*)(GA + (size_t)(r0 + t) * LW + ch0); gav[0] = gp[0]; gav[1] = gp[1]; }
    if (FINAL && MODE == 0 && c == 15 && t >= 125) {
        float* dst = P.out + O_NCP + ((size_t)b * 3 + (t - 125)) * LW + ch0;
#pragma unroll
        for (int q = 0; q < 4; ++q) { *(f32x4*)(dst + 4 * q) = (f32x4){bf2f(raw3[q >> 1][(2 * q) & 3] & 0xffffu), bf2f(raw3[q >> 1][(2 * q) & 3] >> 16), bf2f(raw3[q >> 1][(2 * q + 1) & 3] & 0xffffu), bf2f(raw3[q >> 1][(2 * q + 1) & 3] >> 16)}; }
    }
    if (FINAL && MODE == 1 && (t & 7) >= 5) {
        float* dst = P.out + O_NCS + ((size_t)(idx * 16 + (t >> 3)) * 3 + ((t & 7) - 5)) * LW + ch0;
#pragma unroll
        for (int q = 0; q < 4; ++q) { *(f32x4*)(dst + 4 * q) = (f32x4){bf2f(raw3[q >> 1][(2 * q) & 3] & 0xffffu), bf2f(raw3[q >> 1][(2 * q) & 3] >> 16), bf2f(raw3[q >> 1][(2 * q + 1) & 3] & 0xffffu), bf2f(raw3[q >> 1][(2 * q + 1) & 3] >> 16)}; }
    }
    __syncthreads();
    {
        u32x4 p0, p1;
        p0.x = pk2(xc[0], xc[1]); p0.y = pk2(xc[2], xc[3]); p0.z = pk2(xc[4], xc[5]); p0.w = pk2(xc[6], xc[7]);
        p1.x = pk2(xc[8], xc[9]); p1.y = pk2(xc[10], xc[11]); p1.z = pk2(xc[12], xc[13]); p1.w = pk2(xc[14], xc[15]);
        LAS u32x4* d = (LAS u32x4*)(lds + LRU_XCB + t * XCB_STRIDE + cg * 32); d[0] = p0; d[1] = p1;
        LAS f32x4* f = (LAS f32x4*)(XCF + t * XCF_STRIDE + cg * 16);
#pragma unroll
        for (int q = 0; q < 4; ++q) f[q] = (f32x4){xc[4 * q], xc[4 * q + 1], xc[4 * q + 2], xc[4 * q + 3]};
    }
    if (FINAL && MODE == 0 && tid < 64) {
        const float* sm = SUMM + ((size_t)(b * 16) * 16 + n) * 128 + tid;
        float pj[15], hj[15];
#pragma unroll
        for (int j = 0; j < 15; ++j) { const bool on = j < c; pj[j] = on ? sm[(size_t)j * 2048] : 1.f; hj[j] = on ? sm[(size_t)j * 2048 + 64] : 0.f; }
        float h = SUMMETA[n * 128 + 64 + tid];
#pragma unroll
        for (int j = 0; j < 15; ++j) h = pj[j] * h + hj[j];
        HIN[tid] = h;
    }
    __syncthreads();
    f32x4 Racc[4], Iacc[4];
    {
        bf16x8 af[2];
#pragma unroll
        for (int ks = 0; ks < 2; ++ks) af[ks] = *(const LAS bf16x8*)(lds + LRU_XCB + (16 * w + fr) * XCB_STRIDE + (ks * 32 + fq * 8) * 2);
#pragma unroll
        for (int dt = 0; dt < 4; ++dt) {
            Racc[dt] = (f32x4){0.f, 0.f, 0.f, 0.f}; Iacc[dt] = (f32x4){0.f, 0.f, 0.f, 0.f};
#pragma unroll
            for (int ks = 0; ks < 2; ++ks) {
                const bf16x8 bw = *(const bf16x8*)(waT + (16 * dt + fr) * 64 + ks * 32 + fq * 8);
                const bf16x8 bx = *(const bf16x8*)(wxT + (16 * dt + fr) * 64 + ks * 32 + fq * 8);
                Racc[dt] = __builtin_amdgcn_mfma_f32_16x16x32_bf16(af[ks], bw, Racc[dt], 0, 0, 0);
                Iacc[dt] = __builtin_amdgcn_mfma_f32_16x16x32_bf16(af[ks], bx, Iacc[dt], 0, 0, 0);
            }
        }
    }
    float av[4][4], bv[4][4];
#pragma unroll
    for (int dt = 0; dt < 4; ++dt) {
        const int ch = n * 64 + 16 * dt + fr;
        const float ba = P.in[11][ch], bx = P.in[13][ch];
        const float e = __expf(-P.in[14][ch]);
        const float L2 = -8.0f * 1.4426950409f * (e * (1.0f - e * (0.5f - e * (0.33333333f - 0.25f * e))));
#pragma unroll
        for (int r = 0; r < 4; ++r) {
            const int tk = 16 * w + 4 * fq + r;
            const float rg = fast_sigmoid(Racc[dt][r] + ba), ig = fast_sigmoid(Iacc[dt][r] + bx);
            const float a = __builtin_amdgcn_exp2f(rg * L2);
            float mult = sqrtf(fmaxf(1.0f - a * a, 0.f));
            if (MODE == 2 && tk == 0) mult = 1.0f;
            av[dt][r] = a; bv[dt][r] = mult * ig * XCF[tk * XCF_STRIDE + 16 * dt + fr];
        }
    }
    float Pex[4], Hex[4];
    float Pw[4], Hw[4];
#pragma unroll
    for (int dt = 0; dt < 4; ++dt) {
        float p = av[dt][0], h = bv[dt][0];
#pragma unroll
        for (int r = 1; r < 4; ++r) { h = av[dt][r] * h + bv[dt][r]; p *= av[dt][r]; }
        float p1 = __shfl(p, lane - 16), h1 = __shfl(h, lane - 16);
        float pi = p, hi = h;
        if (fq >= 1) { hi = p * h1 + h; pi = p1 * p; }
        float p2 = __shfl(pi, lane - 32), h2 = __shfl(hi, lane - 32);
        float pi2 = pi, hi2 = hi;
        if (fq >= 2) { hi2 = pi * h2 + hi; pi2 = p2 * pi; }
        const float pe = __shfl(pi2, lane - 16), he = __shfl(hi2, lane - 16);
        if (MODE == 1) {
            Pex[dt] = (fq & 1) ? p1 : 1.f; Hex[dt] = (fq & 1) ? h1 : 0.f;
        } else { Pex[dt] = (fq >= 1) ? pe : 1.f; Hex[dt] = (fq >= 1) ? he : 0.f; }
        Pw[dt] = __shfl(pi2, fr + 48); Hw[dt] = __shfl(hi2, fr + 48);
    }
    float hc[4];
    if (MODE == 1) {
        const int bseq = idx * 16 + 2 * w + (fq >> 1);
#pragma unroll
        for (int dt = 0; dt < 4; ++dt) hc[dt] = P.in[3][(size_t)bseq * LW + n * 64 + 16 * dt + fr];
    } else {
        if (fq == 0) {
#pragma unroll
            for (int dt = 0; dt < 4; ++dt) { WT[(w * 64 + 16 * dt + fr) * 2] = Pw[dt]; WT[(w * 64 + 16 * dt + fr) * 2 + 1] = Hw[dt]; }
        }
        __syncthreads();
        if (!FINAL) {
            if (tid < 64) {
                float p = 1.f, h = 0.f;
                const int nw = (MODE == 2) ? 1 : 8;
#pragma unroll
                for (int ww = 0; ww < 8; ++ww) if (ww < nw) { const float pw = WT[(ww * 64 + tid) * 2], hw = WT[(ww * 64 + tid) * 2 + 1]; h = pw * h + hw; p *= pw; }
                float* dst = (MODE == 2) ? SUMMETA + n * 128 : SUMM + ((size_t)(b * 16 + c) * 16 + n) * 128;
                dst[tid] = p; dst[64 + tid] = h;
            }
            return;
        }
#pragma unroll
        for (int dt = 0; dt < 4; ++dt) {
            float h = HIN[16 * dt + fr];
#pragma unroll
            for (int ww = 0; ww < 7; ++ww) if (ww < w) h = WT[(ww * 64 + 16 * dt + fr) * 2] * h + WT[(ww * 64 + 16 * dt + fr) * 2 + 1];
            hc[dt] = h;
        }
    }
    if (!FINAL) return;
#pragma unroll
    for (int dt = 0; dt < 4; ++dt) {
        float h = Pex[dt] * hc[dt] + Hex[dt];
#pragma unroll
        for (int r = 0; r < 4; ++r) { h = av[dt][r] * h + bv[dt][r]; XCF[(16 * w + 4 * fq + r) * XCF_STRIDE + 16 * dt + fr] = h; }
        if (MODE == 0 && c == 15 && w == 7 && fq == 3) P.out[O_NLP + (size_t)b * LW + n * 64 + 16 * dt + fr] = h;
        if (MODE == 1 && (fq & 1)) P.out[O_NLS + (size_t)(idx * 16 + 2 * w + (fq >> 1)) * LW + n * 64 + 16 * dt + fr] = h;
    }
    __syncthreads();
    {
        const LAS f32x4* f = (const LAS f32x4*)(XCF + t * XCF_STRIDE + cg * 16);
        float g[16];
#pragma unroll
        for (int q = 0; q < 4; ++q) { g[2 * q] = bf2f(gav[0][q] & 0xffffu); g[2 * q + 1] = bf2f(gav[0][q] >> 16); g[8 + 2 * q] = bf2f(gav[1][q] & 0xffffu); g[8 + 2 * q + 1] = bf2f(gav[1][q] >> 16); }
        u32x4 o0, o1; f32x4 h0 = f[0], h1 = f[1], h2 = f[2], h3 = f[3];
        o0.x = pk2(h0[0] * g[0], h0[1] * g[1]); o0.y = pk2(h0[2] * g[2], h0[3] * g[3]); o0.z = pk2(h1[0] * g[4], h1[1] * g[5]); o0.w = pk2(h1[2] * g[6], h1[3] * g[7]);
        o1.x = pk2(h2[0] * g[8], h2[1] * g[9]); o1.y = pk2(h2[2] * g[10], h2[3] * g[11]); o1.z = pk2(h3[0] * g[12], h3[1] * g[13]); o1.w = pk2(h3[2] * g[14], h3[3] * g[15]);
        u32x4* yp = (u32x4*)(YA + (size_t)(r0 + t) * DM + ch0); yp[0] = o0; yp[1] = o1;
    }
}
__device__ __forceinline__ void p2a_lru(const Ctx& C, const Params& P) {
    constexpr int NP = NB * 16 * NBLK, NS = 8 * NBLK, NM = NBLK;
    for (int item = C.vcu; item < NP + NS + NM; item += C.G) {
        if (item < NP) lru_tile<0, false>(C, P, item & 15, item >> 4);
        else if (item < NP + NS) lru_tile<1, true>(C, P, (item - NP) & 15, (item - NP) >> 4);
        else lru_tile<2, false>(C, P, item - NP - NS, 0);
    }
    __syncthreads();
}
__device__ __forceinline__ void p2b_lru(const Ctx& C, const Params& P) {
    constexpr int NP = NB * 16 * NBLK;
    for (int item = C.vcu; item < NP; item += C.G) lru_tile<0, true>(C, P, item & 15, item >> 4);
    __syncthreads();
}

constexpr int RT_STRIDE = 288;
constexpr size_t WS_KVT = WS_H;
constexpr size_t WS_KVMETA = WS_H + 32 * MiB;
__device__ __forceinline__ v4i16_t tr_read(const LAS unsigned char* p) { return __builtin_amdgcn_ds_read_tr16_b64_v4i16((LAS v4i16_t*)p); }
__device__ __forceinline__ bf16x8 cat44(v4i16_t a, v4i16_t b) { return (bf16x8){a[0], a[1], a[2], a[3], b[0], b[1], b[2], b[3]}; }
__device__ __forceinline__ void stage_tile(const Ctx& C, LAS unsigned char* dst, const bf16_t* src, int nvalid) {
    const int m = C.tid >> 2, q = C.tid & 3;
    const u32x4* g = (const u32x4*)(src + (size_t)m * 1024) + q * 4;
    u32x4 v[4];
#pragma unroll
    for (int i = 0; i < 4; ++i) v[i] = (m < nvalid) ? g[i] : (u32x4){0u, 0u, 0u, 0u};
    LAS u32x4* d = (LAS u32x4*)(dst + m * RT_STRIDE + q * 64);
#pragma unroll
    for (int i = 0; i < 4; ++i) d[i] = v[i];
}
__device__ __forceinline__ void ret_kv_item(const Ctx& C, const Params& P, int item) {
    unsigned char* ws = P.ws;
    const bf16_t* K = (const bf16_t*)(ws + WS_K); const bf16_t* V = (const bf16_t*)(ws + WS_V);
    const bool meta = item >= NB * 16 * RH;
    const int h = item & 7, bc = item >> 3;
    const int r0 = meta ? MROW_META : bc * 128;
    float* dst = meta ? (float*)(ws + WS_KVMETA) + (size_t)h * 16384 : (float*)(ws + WS_KVT) + ((size_t)bc * RH + h) * 16384;
    LAS unsigned char* KT = C.lds; LAS unsigned char* VT = C.lds + 128 * RT_STRIDE;
    __syncthreads();
    stage_tile(C, KT, K + (size_t)r0 * 1024 + h * 128, meta ? 16 : 128);
    stage_tile(C, VT, V + (size_t)r0 * 1024 + h * 128, meta ? 16 : 128);
    __syncthreads();
    const int lane = C.lane, w = C.wave, fr = lane & 15, fq = lane >> 4, q = fr >> 2, p = fr & 3;
    const int lofs = q * RT_STRIDE + p * 8;
    bf16x8 af[4];
#pragma unroll
    for (int ks = 0; ks < 4; ++ks) {
        const LAS unsigned char* a0 = VT + (32 * ks + 8 * fq) * RT_STRIDE + (16 * w) * 2 + lofs;
        af[ks] = cat44(tr_read(a0), tr_read(a0 + 4 * RT_STRIDE));
    }
#pragma unroll
    for (int dt = 0; dt < 8; ++dt) {
        f32x4 acc = (f32x4){0.f, 0.f, 0.f, 0.f};
#pragma unroll
        for (int ks = 0; ks < 4; ++ks) {
            const LAS unsigned char* b0 = KT + (32 * ks + 8 * fq) * RT_STRIDE + (16 * dt) * 2 + lofs;
            const bf16x8 bf = cat44(tr_read(b0), tr_read(b0 + 4 * RT_STRIDE));
            acc = __builtin_amdgcn_mfma_f32_16x16x32_bf16(af[ks], bf, acc, 0, 0, 0);
        }
#pragma unroll
        for (int r = 0; r < 4; ++r) dst[(16 * w + 4 * fq + r) * 128 + 16 * dt + fr] = acc[r];
    }
}
__device__ __forceinline__ void ret_prefix_item(const Ctx& C, const Params& P, int item) {
    unsigned char* ws = P.ws;
    const int bh = item >> 3, vs = item & 7, b = bh >> 3, h = bh & 7;
    const int v = 16 * vs + (C.tid >> 5), d4 = (C.tid & 31) * 4, e = v * 128 + d4;
    const float* KVT = (const float*)(ws + WS_KVT); const float* KVM = (const float*)(ws + WS_KVMETA);
    bf16_t* SPT = (bf16_t*)P.out;
    const float lg = lg2gamma(h), g16 = __builtin_amdgcn_exp2f(16.f * lg), g128 = __builtin_amdgcn_exp2f(128.f * lg);
    f32x4 kv[16];
#pragma unroll
    for (int c = 0; c < 16; ++c) kv[c] = *(const f32x4*)(KVT + ((size_t)(b * 16 + c) * RH + h) * 16384 + e);
    f32x4 carry = *(const f32x4*)(KVM + (size_t)h * 16384 + e) * g16;
#pragma unroll
    for (int c = 0; c < 16; ++c) {
        u32x2 wv; wv.x = pk2(carry[0], carry[1]); wv.y = pk2(carry[2], carry[3]);
        *(u32x2*)(SPT + ((size_t)(b * 16 + c) * RH + h) * 16384 + e) = wv;
        carry = (carry + kv[c]) * g128;
    }
    LAS float* tl = (LAS float*)C.lds;
    __syncthreads();
    *(LAS f32x4*)(tl + (C.tid >> 5) * 132 + d4) = carry;
    __syncthreads();
    const int d = C.tid >> 2, v4 = (C.tid & 3) * 4;
    const f32x4 o = (f32x4){tl[(v4 + 0) * 132 + d], tl[(v4 + 1) * 132 + d], tl[(v4 + 2) * 132 + d], tl[(v4 + 3) * 132 + d]};
    *(f32x4*)(P.out + O_NRP + ((size_t)bh * 128 + d) * 128 + 16 * vs + v4) = o;
}
__device__ __forceinline__ void ret_out_item(const Ctx& C, const Params& P, int item) {
    unsigned char* ws = P.ws;
    const bf16_t* Q = (const bf16_t*)(ws + WS_Q); const bf16_t* K = (const bf16_t*)(ws + WS_K); const bf16_t* V = (const bf16_t*)(ws + WS_V); const bf16_t* G = (const bf16_t*)(ws + WS_G);
    bf16_t* YB = (bf16_t*)(ws + WS_YAB) + LW;
    const int h = item & 7, bc = item >> 3, r0 = bc * 128;
    const bf16_t* SPT = (const bf16_t*)P.out + ((size_t)bc * RH + h) * 16384;
    LAS unsigned char* VT = C.lds;
    __syncthreads();
    stage_tile(C, VT, V + (size_t)r0 * 1024 + h * 128, 128);
    const int lane = C.lane, w = C.wave, fr = lane & 15, fq = lane >> 4, q = fr >> 2, p = fr & 3;
    const int lofs = q * RT_STRIDE + p * 8;
    const size_t hoff = (size_t)h * 128;
    bf16x8 qf[4];
#pragma unroll
    for (int ks = 0; ks < 4; ++ks) qf[ks] = *(const bf16x8*)(Q + (size_t)(r0 + 16 * w + fr) * 1024 + hoff + 32 * ks + 8 * fq);
    u32x2 X[8];
#pragma unroll
    for (int mt = 0; mt < 8; ++mt) {
        X[mt] = (u32x2){0u, 0u};
        if (mt <= w) {
            f32x4 acc = (f32x4){0.f, 0.f, 0.f, 0.f};
#pragma unroll
            for (int ks = 0; ks < 4; ++ks) {
                const bf16x8 kf = *(const bf16x8*)(K + (size_t)(r0 + 16 * mt + fr) * 1024 + hoff + 32 * ks + 8 * fq);
                acc = __builtin_amdgcn_mfma_f32_16x16x32_bf16(kf, qf[ks], acc, 0, 0, 0);
            }
            if (mt == w) {
#pragma unroll
                for (int r = 0; r < 4; ++r) acc[r] = (4 * fq + r <= fr) ? acc[r] : 0.f;
            }
            X[mt].x = pk2(acc[0], acc[1]); X[mt].y = pk2(acc[2], acc[3]);
        }
    }
    __syncthreads();
    f32x4 O[8];
#pragma unroll
    for (int vt = 0; vt < 8; ++vt) {
        f32x4 acc = (f32x4){0.f, 0.f, 0.f, 0.f};
#pragma unroll
        for (int ks = 0; ks < 4; ++ks) {
            const bf16x8 sf = *(const bf16x8*)(SPT + (size_t)(16 * vt + fr) * 128 + 32 * ks + 8 * fq);
            acc = __builtin_amdgcn_mfma_f32_16x16x32_bf16(sf, qf[ks], acc, 0, 0, 0);
        }
#pragma unroll
        for (int kk = 0; kk < 4; ++kk) {
            if (2 * kk <= w) {
                const LAS unsigned char* a0 = VT + (32 * kk + 4 * fq) * RT_STRIDE + (16 * vt) * 2 + lofs;
                const bf16x8 vf = cat44(tr_read(a0), tr_read(a0 + 16 * RT_STRIDE));
                bf16x8 xf; { u32x4 t4; t4.x = X[2 * kk].x; t4.y = X[2 * kk].y; t4.z = X[2 * kk + 1].x; t4.w = X[2 * kk + 1].y; xf = __builtin_bit_cast(bf16x8, t4); }
                acc = __builtin_amdgcn_mfma_f32_16x16x32_bf16(vf, xf, acc, 0, 0, 0);
            }
        }
        O[vt] = acc;
    }
    float s = 0.f;
#pragma unroll
    for (int vt = 0; vt < 8; ++vt) s += (O[vt][0] + O[vt][1]) + (O[vt][2] + O[vt][3]);
    s += __shfl_xor(s, 16); s += __shfl_xor(s, 32);
    const float mu = s * (1.f / 128.f);
    float qv = 0.f;
#pragma unroll
    for (int vt = 0; vt < 8; ++vt) { const f32x4 dd = O[vt] - mu; qv += (dd[0] * dd[0] + dd[1] * dd[1]) + (dd[2] * dd[2] + dd[3] * dd[3]); }
    qv += __shfl_xor(qv, 16); qv += __shfl_xor(qv, 32);
    const float rstd = 1.0f / sqrtf(qv * (1.f / 128.f) + EPS);
    const size_t rowoff = (size_t)(r0 + 16 * w + fr) * 1024 + hoff;
#pragma unroll
    for (int vt = 0; vt < 8; ++vt) {
        const int vv = 16 * vt + 4 * fq;
        const f32x4 gnv = *(const f32x4*)(P.in[15] + hoff + vv);
        const u32x2 gg = *(const u32x2*)(G + rowoff + vv);
        const f32x4 y = (O[vt] - mu) * rstd * gnv;
        u32x2 o; o.x = pk2(y[0] * bf2f(gg.x & 0xffffu), y[1] * bf2f(gg.x >> 16)); o.y = pk2(y[2] * bf2f(gg.y & 0xffffu), y[3] * bf2f(gg.y >> 16));
        *(u32x2*)(YB + (size_t)(r0 + 16 * w + fr) * DM + hoff + vv) = o;
    }
}
__device__ __forceinline__ void ret_sample_item(const Ctx& C, const Params& P, int item) {
    unsigned char* ws = P.ws;
    const bf16_t* Q = (const bf16_t*)(ws + WS_Q); const bf16_t* K = (const bf16_t*)(ws + WS_K); const bf16_t* V = (const bf16_t*)(ws + WS_V); const bf16_t* G = (const bf16_t*)(ws + WS_G);
    bf16_t* YB = (bf16_t*)(ws + WS_YAB) + LW;
    const int b = item >> 3, h = item & 7, rb = MP + b * 8;
    LAS float* qs = (LAS float*)C.lds; LAS float* ks = qs + 1024; LAS float* vs = ks + 1024; LAS float* scs = vs + 1024; LAS float* red = scs + 64;
    const int tid = C.tid, v4 = (tid & 31) * 4, dg = tid >> 5;
    const float* S0 = P.in[4] + ((size_t)(b * RH + h) * 128) * 128;
    f32x4 sv[8];
#pragma unroll
    for (int j = 0; j < 8; ++j) sv[j] = *(const f32x4*)(S0 + (size_t)(dg + 16 * j) * 128 + v4);
    __syncthreads();
#pragma unroll
    for (int k = 0; k < 6; ++k) { const int idx = tid + 512 * k, arr = idx >> 10, tok = (idx >> 7) & 7, e = idx & 127;
        const bf16_t* src = (arr == 0) ? Q : (arr == 1) ? K : V;
        qs[idx] = bf2f(src[(size_t)(rb + tok) * 1024 + h * 128 + e]); }
    __syncthreads();
    { const int pair = tid >> 3, part = tid & 7, t = pair >> 3, m = pair & 7; float a = 0.f;
#pragma unroll
      for (int i = 0; i < 16; ++i) a += qs[t * 128 + part * 16 + i] * ks[m * 128 + part * 16 + i];
      a += __shfl_xor(a, 1); a += __shfl_xor(a, 2); a += __shfl_xor(a, 4);
      if (part == 0) scs[pair] = (m <= t) ? a : 0.f; }
    f32x4 vv[8];
#pragma unroll
    for (int m = 0; m < 8; ++m) vv[m] = *(const LAS f32x4*)(vs + m * 128 + v4);
    f32x4 po[8];
#pragma unroll
    for (int t = 0; t < 8; ++t) po[t] = (f32x4){0.f, 0.f, 0.f, 0.f};
    const float g8 = __builtin_amdgcn_exp2f(8.f * lg2gamma(h));
    float* Sn = P.out + O_NRS + ((size_t)(b * RH + h) * 128) * 128;
#pragma unroll
    for (int j = 0; j < 8; ++j) {
        const int d = dg + 16 * j;
        f32x4 sn = sv[j];
#pragma unroll
        for (int t = 0; t < 8; ++t) po[t] += sv[j] * qs[t * 128 + d];
#pragma unroll
        for (int m = 0; m < 8; ++m) sn += vv[m] * ks[m * 128 + d];
        *(f32x4*)(Sn + (size_t)d * 128 + v4) = sn * g8;
    }
#pragma unroll
    for (int t = 0; t < 8; ++t) *(LAS f32x4*)(red + (dg * 8 + t) * 128 + v4) = po[t];
    __syncthreads();
    { const int t = tid >> 6, v2 = (tid & 63) * 2;
      float o0 = 0.f, o1 = 0.f;
#pragma unroll
      for (int g = 0; g < 16; ++g) { const f32x2 r = *(const LAS f32x2*)(red + (g * 8 + t) * 128 + v2); o0 += r[0]; o1 += r[1]; }
#pragma unroll
      for (int m = 0; m < 8; ++m) { const float sc = scs[t * 8 + m]; const f32x2 r = *(const LAS f32x2*)(vs + m * 128 + v2); o0 += sc * r[0]; o1 += sc * r[1]; }
      const float mu = wave_sum(o0 + o1) * (1.f / 128.f);
      const float d0 = o0 - mu, d1 = o1 - mu;
      const float rstd = 1.0f / sqrtf(wave_sum(d0 * d0 + d1 * d1) * (1.f / 128.f) + EPS);
      const size_t off = (size_t)(rb + t) * 1024 + h * 128 + v2;
      const unsigned gg = *(const unsigned*)(G + off);
      const f32x2 gnv = *(const f32x2*)(P.in[15] + h * 128 + v2);
      *(unsigned*)(YB + (size_t)(rb + t) * DM + h * 128 + v2) = pk2(d0 * rstd * gnv[0] * bf2f(gg & 0xffffu), d1 * rstd * gnv[1] * bf2f(gg >> 16)); }
}
__device__ __forceinline__ void p2a_ret(const Ctx& C, const Params& P) {
    for (int item = C.vcu; item < NB * 16 * RH + RH; item += C.G) ret_kv_item(C, P, item);
    __syncthreads();
}
__device__ __forceinline__ void p2m_ret(const Ctx& C, const Params& P) {
    for (int item = C.vcu; item < NB * RH * 8; item += C.G) ret_prefix_item(C, P, item);
    for (int item = C.vcu; item < DECB * RH; item += C.G) ret_sample_item(C, P, item);
    __syncthreads();
}
__device__ __forceinline__ void p2b_ret(const Ctx& C, const Params& P) {
    for (int item = C.vcu; item < NB * 16 * RH; item += C.G) ret_out_item(C, P, item);
    __syncthreads();
}
__device__ __forceinline__ void p7_final_norm(const Ctx& C, const Params& P) {
    const float* gf = P.in[22]; const float* SL = (const float*)(P.ws + WS_SLAB1);
    const int gw = C.vcu * NWAVES + C.wave, NGW = C.G * NWAVES;
    for (int m = gw; m < M; m += NGW) {
        f32x4* xr = (f32x4*)(P.out + (size_t)m * DM) + C.lane; const f32x4* sr = (const f32x4*)(SL + (size_t)m * DM) + C.lane; const f32x4* gr = (const f32x4*)gf + C.lane;
        f32x4 v[8]; float s = 0.f;
#pragma unroll
        for (int j = 0; j < 8; ++j) { v[j] = xr[64 * j] + sr[64 * j]; s += (v[j][0] * v[j][0] + v[j][1] * v[j][1]) + (v[j][2] * v[j][2] + v[j][3] * v[j][3]); }
        const float rstd = 1.0f / sqrtf(wave_sum(s) * (1.f / DM) + EPS);
#pragma unroll
        for (int j = 0; j < 8; ++j) xr[64 * j] = v[j] * rstd * gr[64 * j];
    }
}

constexpr int NPHASE = 10;
__global__ void __launch_bounds__(NTHR, 2) mega_fwd(Params P) {
    extern __shared__ __attribute__((aligned(16))) unsigned char lds_raw[];
    Ctx C;
    C.lds = (LAS unsigned char*)lds_raw;
    C.tid = threadIdx.x; C.lane = C.tid & 63; C.wave = __builtin_amdgcn_readfirstlane(C.tid >> 6);
    C.G = gridDim.x; { const int bx = blockIdx.x; C.vcu = (C.G % 8 == 0) ? (bx % 8) * (C.G / 8) + bx / 8 : bx; }
    volatile LAS unsigned* MISC = (volatile LAS unsigned*)(C.lds + MISC_OFF);
    for (int u = C.tid; u < (LDS_BYTES - LDSCTL_OFF) / 4; u += NTHR) ((LAS unsigned*)(C.lds + LDSCTL_OFF))[u] = 0u;
    __syncthreads();
    unsigned char* ws = P.ws;
    XcdBarrier bar; bar.bar = (unsigned*)(ws + WS_CTL) + CW_BAR; bar.x = 0; bar.st = nullptr;
    const bool one_launch = (P.ph_hi - P.ph_lo) > 1;
    if (one_launch) bar = xcd_barrier_post((unsigned*)(ws + WS_CTL) + CW_BAR, MISC + 8);
    const int lo = P.ph_lo, hi = P.ph_hi;
#define IN(k) (lo <= (k) && (k) < hi)
#define SEAM(k) do { if (IN(k) && IN((k) + 1)) xcd_barrier(bar); } while (0)
    if (IN(0)) { p0_prep(C, P); } SEAM(0);
    if (IN(1)) {
        pg8::TileOrder S; S.init(37, 40, C.G, (int)blockIdx.x);
        EpiProj E{(bf16_t*)(ws + WS_XA), (bf16_t*)(ws + WS_GA), (bf16_t*)(ws + WS_Q), (bf16_t*)(ws + WS_K), (bf16_t*)(ws + WS_V), (bf16_t*)(ws + WS_G), (bf16_t*)(ws + WS_SA), (bf16_t*)(ws + WS_SB),
                  (const float*)(ws + WS_TAB), (const float*)(ws + WS_TAB) + TABROWS * 64};
        pg8::gemm_phase<EpiProj, true, true>(C.lds, (const bf16_t*)(ws + WS_H), (const bf16_t*)(ws + WS_WIN), DM, S, E);
    } SEAM(1);
    if (IN(2)) { p2a_lru(C, P); p2a_ret(C, P); } SEAM(2);
    if (IN(3)) { p2m_ret(C, P); } SEAM(3);
    if (IN(4)) { p2b_lru(C, P); p2b_ret(C, P); } SEAM(4);
    {
        const StreamPtrs T{(const bf16_t*)(ws + WS_YAB), (const bf16_t*)(ws + WS_PA), (const bf16_t*)(ws + WS_PB), (const bf16_t*)(ws + WS_MERGED), (const bf16_t*)(ws + WS_WOUT),
                           (const bf16_t*)(ws + WS_X1N), (const bf16_t*)(ws + WS_WUP), (const bf16_t*)(ws + WS_U), (const bf16_t*)(ws + WS_WDN)};
        const StreamEpi E{(const bf16_t*)(ws + WS_SA), (bf16_t*)(ws + WS_SB), P.in[0], P.in[1], P.out, (bf16_t*)(ws + WS_X1N), P.in[19], (float*)(ws + WS_SS), (bf16_t*)(ws + WS_U), (float*)(ws + WS_SLAB1)};
        if (IN(5)) { pg8::gemm_stream(C.lds, T, E, C.vcu, 0, 1); } SEAM(5);
        if (IN(6)) { pg8::gemm_stream(C.lds, T, E, C.vcu, 2, 2); } SEAM(6);
        if (IN(7)) { pg8::gemm_stream(C.lds, T, E, C.vcu, 3, 3); } SEAM(7);
        if (IN(8)) { pg8::gemm_stream(C.lds, T, E, C.vcu, 4, 5); } SEAM(8);
    }
    if (IN(9)) { p7_final_norm(C, P); }
#undef IN
#undef SEAM
}

extern "C" void kernel_launch(void* const* d_in, const int* in_sizes, int n_in, void* d_out, int out_size, void* d_ws, size_t ws_size, hipStream_t stream) {
    static int grid = 0;
    if (grid == 0) {
        if (n_in != 23 || (size_t)out_size != O_END || ws_size < WS_END) { fprintf(stderr, "kernel_launch: unexpected sizes n_in %d out %d ws %zu (need %zu)\n", n_in, out_size, ws_size, (size_t)WS_END); grid = -1; return; }
        int dev = 0, cus = 0, per_cu = 0;
        if (hipGetDevice(&dev) != hipSuccess || hipDeviceGetAttribute(&cus, hipDeviceAttributeMultiprocessorCount, dev) != hipSuccess) { grid = -1; return; }
        if (hipFuncSetAttribute((const void*)mega_fwd, hipFuncAttributeMaxDynamicSharedMemorySize, LDS_BYTES) != hipSuccess) { fprintf(stderr, "kernel_launch: hipFuncSetAttribute failed\n"); grid = -1; return; }
        if (hipOccupancyMaxActiveBlocksPerMultiprocessor(&per_cu, (const void*)mega_fwd, NTHR, LDS_BYTES) != hipSuccess || per_cu < 1) { fprintf(stderr, "kernel_launch: occupancy query says %d blocks per CU\n", per_cu); (void)hipGetLastError(); grid = -1; return; }
        grid = cus;
    }
    if (grid < 0) return;
    if (hipMemsetAsync((char*)d_ws + WS_CTL, 0, CTL_ZERO_BYTES, stream) != hipSuccess) return;
    Params a{};
    for (int i = 0; i < 23; ++i) a.in[i] = (const float*)d_in[i];
    a.out = (float*)d_out; a.ws = (unsigned char*)d_ws;
#if MK_N_LAUNCHES == 1
    a.ph_lo = 0; a.ph_hi = NPHASE; a.li = 0;
    hipLaunchKernelGGL(mega_fwd, dim3(grid), dim3(NTHR), LDS_BYTES, stream, a);
#else
    for (int li = 0; li < NPHASE; ++li) { a.ph_lo = li; a.ph_hi = li + 1; a.li = li; hipLaunchKernelGGL(mega_fwd, dim3(grid), dim3(NTHR), LDS_BYTES, stream, a); }
#endif
}
```
